# Optimizing an MI355X kernel written in HIP

```python
import jax, jax.numpy as jnp
from jax import lax
import numpy as np

D_MODEL = 2048
BATCH = 4
SEQ = 4096
DEPTH = 2

N_MIXERS = 2
N_A = (DEPTH + 1) // 2
N_B = DEPTH // 2
CHUNK = 128
A_WIDTH = D_MODEL
A_GROUPS = 16
A_GROUP_DIM = A_WIDTH // A_GROUPS
B_HEADS = 16
B_HEAD_DIM = D_MODEL // B_HEADS
Q_BLOCK = 128
FFN_HIDDEN = ((-(-8 * D_MODEL // 3) + 255) // 256) * 256
N_MOD = 6
EPS = 1e-6

kernel_name = "hybrid_sgu_fox_adaln_trunk"


def rms_norm(x, g):
    xf = x.astype(jnp.float32)
    y = xf * lax.rsqrt(jnp.mean(xf * xf, axis=-1, keepdims=True) + EPS)
    return (y * g.astype(jnp.float32)).astype(x.dtype)


def layer_norm(x, g, b):
    xf = x.astype(jnp.float32)
    mu = jnp.mean(xf, axis=-1, keepdims=True)
    var = jnp.mean(jnp.square(xf - mu), axis=-1, keepdims=True)
    y = (xf - mu) * lax.rsqrt(var + EPS)
    return (y * g.astype(jnp.float32) + b.astype(jnp.float32)).astype(x.dtype)


def modulate(h, shift, scale):
    return h * (1 + scale[:, None, :]) + shift[:, None, :]


def chunk_sgu_mixer(h, w_in, b_in, ln_g, ln_b, w_s, b_s, w_out):
    B, S, _ = h.shape
    z = jax.nn.gelu(h @ w_in + b_in, approximate=False)
    u, v = jnp.split(z, 2, axis=-1)
    v = layer_norm(v, ln_g, ln_b)
    causal = jnp.tril(jnp.ones((CHUNK, CHUNK), dtype=bool))
    w = jnp.where(causal[None], w_s, 0).astype(v.dtype)
    vc = v.reshape(B, S // CHUNK, CHUNK, A_GROUPS, A_GROUP_DIM)
    sv = jnp.einsum('gts,bnsgc->bntgc', w, vc) + b_s.T[None, None, :, :, None].astype(v.dtype)
    y = u * sv.reshape(B, S, A_WIDTH)
    return y @ w_out


def forgetting_attention(h, w_in, b_f, w_out):
    B, S, D = h.shape
    proj = h @ w_in
    q, k, v, f_logit = jnp.split(proj, [D, 2 * D, 3 * D], axis=-1)
    q = q.reshape(B, S, B_HEADS, B_HEAD_DIM).transpose(0, 2, 1, 3)
    k = k.reshape(B, S, B_HEADS, B_HEAD_DIM).transpose(0, 2, 1, 3)
    v = v.reshape(B, S, B_HEADS, B_HEAD_DIM).transpose(0, 2, 1, 3)
    log_f = jax.nn.log_sigmoid(f_logit.astype(jnp.float32) + b_f.astype(jnp.float32))
    F = jnp.cumsum(log_f, axis=1).transpose(0, 2, 1)
    n_blk = S // Q_BLOCK
    q_blocks = q.reshape(B, B_HEADS, n_blk, Q_BLOCK, B_HEAD_DIM).transpose(2, 0, 1, 3, 4)
    F_blocks = F.reshape(B, B_HEADS, n_blk, Q_BLOCK).transpose(2, 0, 1, 3)
    k_pos = jnp.arange(S)
    scale = 1.0 / float(np.sqrt(B_HEAD_DIM))

    def attend_block(args):
        q_blk, F_blk, i = args
        q_pos = i * Q_BLOCK + jnp.arange(Q_BLOCK)
        s = jnp.einsum('bhqd,bhkd->bhqk', q_blk, k).astype(jnp.float32) * scale
        s = s + F_blk[..., None] - F[:, :, None, :]
        s = jnp.where(k_pos[None, :] <= q_pos[:, None], s, -jnp.inf)
        p = jax.nn.softmax(s, axis=-1).astype(v.dtype)
        return jnp.einsum('bhqk,bhkd->bhqd', p, v)

    o = lax.map(attend_block, (q_blocks, F_blocks, jnp.arange(n_blk)))
    o = o.transpose(1, 0, 3, 2, 4).reshape(B, S, D)
    return o @ w_out


def swiglu_ffn(h, w_gate, w_up, w_down):
    return (jax.nn.silu(h @ w_gate) * (h @ w_up)) @ w_down


def setup_inputs(seed: int = 0) -> dict:
    key = jax.random.key(seed)
    ks = jax.random.split(key, 24)
    D, F_H, AW = D_MODEL, FFN_HIDDEN, A_WIDTH
    nrm = lambda k, shape, s: jax.random.normal(k, shape, jnp.float32) * s
    x = nrm(ks[0], (BATCH, SEQ, D), 1.0)
    c = nrm(ks[1], (BATCH, D), 1.0)
    ada_w = nrm(ks[2], (DEPTH, D, N_MOD * D), 0.5 * D ** -0.5)
    ada_b = nrm(ks[3], (DEPTH, N_MOD * D), 0.02)
    norm_mix_g = 1.0 + nrm(ks[4], (DEPTH, D), 0.02)
    norm_ffn_g = 1.0 + nrm(ks[5], (DEPTH, D), 0.02)
    a_w_in = nrm(ks[6], (N_A, D, 2 * AW), D ** -0.5)
    a_b_in = nrm(ks[7], (N_A, 2 * AW), 0.02)
    a_ln_g = 1.0 + nrm(ks[8], (N_A, AW), 0.02)
    a_ln_b = nrm(ks[9], (N_A, AW), 0.02)
    a_w_s = nrm(ks[10], (N_A, A_GROUPS, CHUNK, CHUNK), CHUNK ** -0.5)
    a_b_s = 1.0 + nrm(ks[11], (N_A, A_GROUPS, CHUNK), 0.02)
    a_w_out = nrm(ks[12], (N_A, AW, D), AW ** -0.5)
    b_w_qkv = nrm(ks[13], (N_B, D, 3 * D), D ** -0.5)
    b_w_f = nrm(ks[14], (N_B, D, B_HEADS), 0.5 * D ** -0.5)
    b_w_in = jnp.concatenate([b_w_qkv, b_w_f], axis=-1)
    b_b_f = jax.random.uniform(ks[15], (N_B, B_HEADS), jnp.float32, 1.0, 6.0)
    b_w_out = nrm(ks[16], (N_B, D, D), D ** -0.5)
    ffn_w_gate = nrm(ks[17], (DEPTH, D, F_H), D ** -0.5)
    ffn_w_up = nrm(ks[18], (DEPTH, D, F_H), D ** -0.5)
    ffn_w_down = nrm(ks[19], (DEPTH, F_H, D), F_H ** -0.5)
    final_g = 1.0 + nrm(ks[20], (D,), 0.02)
    return {"x": x, "c": c, "ada_w": ada_w, "ada_b": ada_b,
            "norm_mix_g": norm_mix_g, "norm_ffn_g": norm_ffn_g,
            "a_w_in": a_w_in, "a_b_in": a_b_in, "a_ln_g": a_ln_g, "a_ln_b": a_ln_b,
            "a_w_s": a_w_s, "a_b_s": a_b_s, "a_w_out": a_w_out,
            "b_w_in": b_w_in, "b_b_f": b_b_f, "b_w_out": b_w_out,
            "ffn_w_gate": ffn_w_gate, "ffn_w_up": ffn_w_up, "ffn_w_down": ffn_w_down,
            "final_g": final_g}


def reference(x, c, ada_w, ada_b, norm_mix_g, norm_ffn_g,
              a_w_in, a_b_in, a_ln_g, a_ln_b, a_w_s, a_b_s, a_w_out,
              b_w_in, b_b_f, b_w_out,
              ffn_w_gate, ffn_w_up, ffn_w_down, final_g):
    c_act = jax.nn.silu(c)
    for i in range(DEPTH):
        mod = c_act @ ada_w[i] + ada_b[i]
        sh1, sc1, g1, sh2, sc2, g2 = jnp.split(mod, N_MOD, axis=-1)
        h = modulate(rms_norm(x, norm_mix_g[i]), sh1, sc1)
        j = i // N_MIXERS
        if i % N_MIXERS == 0:
            y = chunk_sgu_mixer(h, a_w_in[j], a_b_in[j], a_ln_g[j], a_ln_b[j],
                                a_w_s[j], a_b_s[j], a_w_out[j])
        else:
            y = forgetting_attention(h, b_w_in[j], b_b_f[j], b_w_out[j])
        x = x + g1[:, None, :] * y
        h = modulate(rms_norm(x, norm_ffn_g[i]), sh2, sc2)
        x = x + g2[:, None, :] * swiglu_ffn(h, ffn_w_gate[i], ffn_w_up[i], ffn_w_down[i])
    return rms_norm(x, final_g)
```

```cpp
#include <hip/hip_runtime.h>
#include <hip/hip_cooperative_groups.h>
#include <cstdio>
#include <cstdint>
namespace cg = cooperative_groups;
#ifndef PG8_WGM
#define PG8_WGM 2
#endif
namespace pg8 {
#define PG8_LAS __attribute__((address_space(3)))
typedef unsigned short bf16_t;
typedef short bf16x8 __attribute__((ext_vector_type(8)));
typedef float f32x4 __attribute__((ext_vector_type(4)));
typedef unsigned u32x4 __attribute__((ext_vector_type(4)));
constexpr int BM = 256, BK = 64, HALF = 128, HTB = HALF * BK * 2  , STAGE_BYTES = 8 * HTB, NXCD = 8, WGM = PG8_WGM;

__host__ __device__ __forceinline__ int lds_byte(int r, int c) { const int st = (r >> 4) * 2 + (c >> 5), rr = r & 15, cc = c & 31, ob = rr * 64 + cc * 2; return st * 1024 + (ob ^ (((ob >> 9) & 1) << 5)); }
__host__ __device__ __forceinline__ void stage_rc(int b, int& R, int& C) { const int st = b / 1024, sb = b % 1024, swz = sb ^ (((sb >> 9) & 1) << 5); R = (st >> 1) * 16 + swz / 64; C = (st & 1) * 32 + (swz % 64) / 2; }
__host__ __device__ __forceinline__ int perm32(int rho) { const int n = rho >> 4, i = rho & 15; return 8 * (i >> 2) + 4 * n + (i & 3); }

struct Unit { int pm, pn; };
struct Gemm { const bf16_t* A; const bf16_t* Bt; int M, N, K; };

struct StaticOrder {
    int nM, nN, nwg, G, c;
    __host__ __device__ void init(int M, int N, int G_, int c_) { nM = M / BM; nN = N / BM; nwg = nM * nN; G = G_; c = c_; }
    __host__ __device__ bool next(int i, Unit& u) const {
        const long L = (long)i * G + c; if (L >= nwg) return false;
        int wgid = (int)L; { const int q = nwg / NXCD, r = nwg % NXCD, xcd = wgid % NXCD, off = wgid / NXCD; wgid = (xcd < r ? xcd * (q + 1) : r * (q + 1) + (xcd - r) * q) + off; }
        const int nig = WGM * nN, gid = wgid / nig, fm = gid * WGM, gsz = (nM - fm) < WGM ? (nM - fm) : WGM;
        u.pm = fm + ((wgid % nig) % gsz); u.pn = (wgid % nig) / gsz; return true;
    }
    __device__ __forceinline__ void a_ready(const Unit&) const {}
    __device__ __forceinline__ void done(const Unit&) const {}
};

__device__ __forceinline__ unsigned cvt_pk_bf16(float lo, float hi) { unsigned r; asm volatile("v_cvt_pk_bf16_f32 %0, %1, %2" : "=v"(r) : "v"(lo), "v"(hi)); return r; }
typedef float f32x2 __attribute__((ext_vector_type(2)));
__device__ __forceinline__ f32x2 gelu_pk(f32x2 v) {
    const f32x2 av = __builtin_elementwise_abs(v), d = av * 0.2316418882f + 1.0f;
    f32x2 t; t.x = __builtin_amdgcn_rcpf(d.x); t.y = __builtin_amdgcn_rcpf(d.y);
    f32x2 q = t * 0.5307027145f + (-0.7265760135f); q = q * t + 0.7107068705f; q = q * t + (-0.142248368f); q = q * t + 0.127414796f; q = q * t;
    const f32x2 s = (v * v) * (-0.72134752044f);
    f32x2 e; e.x = __builtin_amdgcn_exp2f(s.x); e.y = __builtin_amdgcn_exp2f(s.y);
    const f32x2 m = v * (q * e), r = v - m;
    f32x2 o; o.x = v.x < 0.f ? m.x : r.x; o.y = v.y < 0.f ? m.y : r.y; return o;
}

template <int ACT  > struct EpiBf16 {
    static constexpr bool PERM = true, AFTER_DRAIN = false; static_assert(ACT == 0 || ACT == 1, "EpiBf16: ACT is 0 (none) or 1 (gelu_pk)");
    bf16_t* O; int ldc; const float* bias; int split_cols; size_t split_stride; float scale0;
    __device__ __forceinline__ void operator()(const f32x4 (&acc)[2][2][4][2], const Unit& u, int wr, int wc, int fr, int fq) const {
        const int row0 = u.pm * BM + wr * 64 + fr; int colt = u.pn * BM; bf16_t* base = O;
        float sc = 1.f; if (split_cols) { const int t = colt / split_cols; base += (size_t)t * split_stride; colt -= t * split_cols; if (t == 0) sc = scale0; }
        const int col0 = colt + wc * 32 + 8 * fq, bcol0 = u.pn * BM + wc * 32 + 8 * fq;
        f32x4 bv[2][2];
#pragma unroll
        for (int bj = 0; bj < 2; ++bj)
#pragma unroll
            for (int n = 0; n < 2; ++n) bv[bj][n] = bias ? *(const f32x4*)(bias + bcol0 + bj * HALF + 4 * n) : (f32x4){0.f, 0.f, 0.f, 0.f};
#pragma unroll
        for (int ai = 0; ai < 2; ++ai)
#pragma unroll
            for (int m = 0; m < 4; ++m) { bf16_t* rowp = base + (size_t)(row0 + ai * HALF + m * 16) * ldc + col0;
#pragma unroll
                for (int bj = 0; bj < 2; ++bj) { f32x4 v0 = acc[ai][bj][m][0] + bv[bj][0], v1 = acc[ai][bj][m][1] + bv[bj][1];
                    if (ACT == 1) { f32x2 a = gelu_pk((f32x2){v0[0], v0[1]}), b = gelu_pk((f32x2){v0[2], v0[3]}), c = gelu_pk((f32x2){v1[0], v1[1]}), d = gelu_pk((f32x2){v1[2], v1[3]});
                        v0 = (f32x4){a.x, a.y, b.x, b.y}; v1 = (f32x4){c.x, c.y, d.x, d.y}; }
                    v0 = v0 * sc; v1 = v1 * sc; u32x4 w; w.x = cvt_pk_bf16(v0[0], v0[1]); w.y = cvt_pk_bf16(v0[2], v0[3]); w.z = cvt_pk_bf16(v1[0], v1[1]); w.w = cvt_pk_bf16(v1[2], v1[3]);
                    *(u32x4*)(rowp + bj * HALF) = w; } }
    }
};
template <class Epi, class Sched, bool ALIGN_EPI = false, bool SP2 = false>
__device__ __forceinline__ void gemm_phase(PG8_LAS unsigned char* lds, const Gemm g, const Sched& S, const Epi& E) {
    int tid_ = threadIdx.x; asm volatile("" : "+v"(tid_)); const int tid = tid_, wid = __builtin_amdgcn_readfirstlane(tid >> 6), lane = tid & 63, wr = wid >> 2, wc = wid & 3, fr = lane & 15, fq = lane >> 4;
    const int K = g.K, nt = K / BK;
    unsigned voffA[2], voffB[2];
#pragma unroll
    for (int i = 0; i < 2; ++i) { int R, C; stage_rc(tid * 16 + i * 8192, R, C); const int Rb = Epi::PERM ? ((R & ~31) + perm32(R & 31)) : R;
        voffA[i] = (unsigned)(R * K + C) * 2u; voffB[i] = (unsigned)(Rb * K + C) * 2u; }
    const size_t kstep = (size_t)(BK * 2);
    const size_t hstep = (size_t)HALF * K * 2;
    const size_t tstep = 2 * hstep;
    const unsigned ldsw = (unsigned)wid * 1024u;
    const int aoff = lds_byte(wr * 64 + fr, fq * 8), boff = lds_byte(wc * 32 + fr, fq * 8);
#define PG8_SA(b, h) (((b) * 2 + (h)) * HTB)
#define PG8_SB(b, h) ((4 + (b) * 2 + (h)) * HTB)
#define PG8_STAGE(bufoff, gbase, voff) do { _Pragma("unroll") for (int _i = 0; _i < 2; ++_i) \
        __builtin_amdgcn_global_load_lds((const unsigned*)((const char*)(gbase) + (voff)[_i]), (PG8_LAS unsigned*)(lds + (bufoff) + ldsw + _i * 8192), 16, 0, 0); } while (0)
#define PG8_LDA(dst, b, h) do { _Pragma("unroll") for (int m = 0; m < 4; ++m) _Pragma("unroll") for (int k = 0; k < 2; ++k) dst[m][k] = *(const PG8_LAS bf16x8*)(lds + PG8_SA(b, h) + aoff + m * 2048 + k * 1024); } while (0)
#define PG8_LDB(dst, b, h) do { _Pragma("unroll") for (int n = 0; n < 2; ++n) _Pragma("unroll") for (int k = 0; k < 2; ++k) dst[n][k] = *(const PG8_LAS bf16x8*)(lds + PG8_SB(b, h) + boff + n * 2048 + k * 1024); } while (0)
#define PG8_MMA(ai, bj, At, Bt) do { __builtin_amdgcn_s_setprio(1); _Pragma("unroll") for (int m = 0; m < 4; ++m) _Pragma("unroll") for (int n = 0; n < 2; ++n) _Pragma("unroll") for (int k = 0; k < 2; ++k) \
        acc[ai][bj][m][n] = __builtin_amdgcn_mfma_f32_16x16x32_bf16(Bt[n][k], At[m][k], acc[ai][bj][m][n], 0, 0, 0); __builtin_amdgcn_s_setprio(0); } while (0)
#define PG8_WAIT_V(n) asm volatile("s_waitcnt vmcnt(" #n ")" ::: "memory")
#define PG8_WAIT_L(n) asm volatile("s_waitcnt lgkmcnt(" #n ")" ::: "memory")
#define PG8_BAR __builtin_amdgcn_s_barrier()
#define PG8_SCHED __builtin_amdgcn_sched_barrier(0)
    Unit cur, nxt; int ui = 0;
    if (!S.next(0, cur)) return;
    f32x4 acc[2][2][4][2];
#pragma unroll
    for (int a = 0; a < 2; ++a)
#pragma unroll
        for (int b = 0; b < 2; ++b)
#pragma unroll
            for (int m = 0; m < 4; ++m)
#pragma unroll
                for (int n = 0; n < 2; ++n) acc[a][b][m][n] = (f32x4){0.f, 0.f, 0.f, 0.f};
    bf16x8 At[4][2], B0[2][2], B1[2][2];
    const char* cA = (const char*)g.A + (size_t)cur.pm * tstep; const char* cB = (const char*)g.Bt + (size_t)cur.pn * tstep;
    S.a_ready(cur);
    if constexpr (SP2) {
        PG8_STAGE(PG8_SB(0, 0), cB, voffB); PG8_STAGE(PG8_SB(0, 1), cB + hstep, voffB); PG8_STAGE(PG8_SA(0, 0), cA, voffA); PG8_STAGE(PG8_SA(0, 1), cA + hstep, voffA);
        if (wr == 1) PG8_BAR;
        PG8_WAIT_V(2); PG8_BAR;
        PG8_STAGE(PG8_SB(1, 0), cB + kstep, voffB); PG8_STAGE(PG8_SA(1, 0), cA + kstep, voffA); PG8_STAGE(PG8_SB(1, 1), cB + hstep + kstep, voffB);
        PG8_WAIT_V(6); PG8_BAR;
    } else {
        PG8_STAGE(PG8_SB(0, 0), cB, voffB); PG8_STAGE(PG8_SA(0, 0), cA, voffA); PG8_STAGE(PG8_SB(0, 1), cB + hstep, voffB); PG8_STAGE(PG8_SA(0, 1), cA + hstep, voffA);
        if (wr == 1) PG8_BAR;
        PG8_WAIT_V(4); PG8_BAR;
        PG8_STAGE(PG8_SB(1, 0), cB + kstep, voffB); PG8_STAGE(PG8_SA(1, 0), cA + kstep, voffA); PG8_STAGE(PG8_SB(1, 1), cB + hstep + kstep, voffB);
        PG8_WAIT_V(6); PG8_BAR;
    }
    for (;;) {
        const bool has_next = S.next(ui + 1, nxt);
        const char* nA = has_next ? (const char*)g.A + (size_t)nxt.pm * tstep : cA; const char* nB = has_next ? (const char*)g.Bt + (size_t)nxt.pn * tstep : cB;
        for (int t = 0; t < nt; t += 2) {
            const bool last = (t == nt - 2);
            const char* a1 = cA + (size_t)(t + 1) * kstep;
            const char* a2 = last ? nA : cA + (size_t)(t + 2) * kstep; const char* b2 = last ? nB : cB + (size_t)(t + 2) * kstep;
            const char* a3 = a2 + kstep; const char* b3 = b2 + kstep;
            if (last && has_next) S.a_ready(nxt);
            if constexpr (SP2) {
            PG8_LDB(B0, 0, 0); PG8_LDB(B1, 0, 1); PG8_SCHED; PG8_LDA(At, 0, 0); PG8_STAGE(PG8_SA(1, 1), a1 + hstep, voffA);
            PG8_WAIT_V(8); PG8_WAIT_L(0); PG8_BAR; PG8_MMA(0, 0, At, B0); PG8_MMA(0, 1, At, B1); PG8_BAR; PG8_SCHED;
            PG8_LDA(At, 0, 1); PG8_STAGE(PG8_SB(0, 0), b2, voffB); PG8_STAGE(PG8_SB(0, 1), b2 + hstep, voffB); PG8_STAGE(PG8_SA(0, 0), a2, voffA);
            PG8_WAIT_V(8); PG8_WAIT_L(0); PG8_BAR; PG8_MMA(1, 0, At, B0); PG8_MMA(1, 1, At, B1); PG8_BAR; PG8_SCHED;
            PG8_LDB(B0, 1, 0); PG8_LDB(B1, 1, 1); PG8_SCHED; PG8_LDA(At, 1, 0); PG8_STAGE(PG8_SA(0, 1), a2 + hstep, voffA);
            PG8_WAIT_V(8); PG8_WAIT_L(0); PG8_BAR; PG8_MMA(0, 0, At, B0); PG8_MMA(0, 1, At, B1); PG8_BAR; PG8_SCHED;
            PG8_LDA(At, 1, 1); PG8_STAGE(PG8_SB(1, 0), b3, voffB); PG8_STAGE(PG8_SB(1, 1), b3 + hstep, voffB); PG8_STAGE(PG8_SA(1, 0), a3, voffA);
            PG8_WAIT_V(8); PG8_WAIT_L(0); PG8_BAR; PG8_MMA(1, 0, At, B0); PG8_MMA(1, 1, At, B1); PG8_BAR; PG8_SCHED;
            } else {
            PG8_LDB(B0, 0, 0); PG8_SCHED; PG8_LDA(At, 0, 0); PG8_STAGE(PG8_SA(1, 1), a1 + hstep, voffA);
            PG8_WAIT_L(8); PG8_BAR; PG8_WAIT_L(0); PG8_MMA(0, 0, At, B0); PG8_BAR; PG8_SCHED;
            PG8_LDB(B1, 0, 1); PG8_STAGE(PG8_SB(0, 0), b2, voffB);
            PG8_BAR; PG8_WAIT_L(0); PG8_MMA(0, 1, At, B1); PG8_BAR;
            PG8_LDA(At, 0, 1); PG8_STAGE(PG8_SA(0, 0), a2, voffA);
            PG8_BAR; PG8_WAIT_L(0); PG8_MMA(1, 0, At, B0); PG8_BAR; PG8_SCHED;
            PG8_STAGE(PG8_SB(0, 1), b2 + hstep, voffB);
            PG8_WAIT_V(6); PG8_BAR; PG8_MMA(1, 1, At, B1); PG8_BAR;
            PG8_LDB(B0, 1, 0); PG8_SCHED; PG8_LDA(At, 1, 0); PG8_STAGE(PG8_SA(0, 1), a2 + hstep, voffA);
            PG8_WAIT_L(8); PG8_BAR; PG8_WAIT_L(0); PG8_MMA(0, 0, At, B0); PG8_BAR; PG8_SCHED;
            PG8_LDB(B1, 1, 1); PG8_STAGE(PG8_SB(1, 0), b3, voffB);
            PG8_BAR; PG8_WAIT_L(0); PG8_MMA(0, 1, At, B1); PG8_BAR;
            PG8_LDA(At, 1, 1); PG8_STAGE(PG8_SA(1, 0), a3, voffA);
            PG8_BAR; PG8_WAIT_L(0); PG8_MMA(1, 0, At, B0); PG8_BAR; PG8_SCHED;
            PG8_STAGE(PG8_SB(1, 1), b3 + hstep, voffB);
            PG8_WAIT_V(6); PG8_BAR; PG8_MMA(1, 1, At, B1); PG8_BAR;
            }
        }
        if constexpr (ALIGN_EPI) { if (wr == 0) PG8_BAR; }
        if constexpr (!Epi::AFTER_DRAIN) { E(acc, cur, wr, wc, fr, fq); S.done(cur); }
        if (!has_next) break;
#pragma unroll
        for (int a = 0; a < 2; ++a)
#pragma unroll
            for (int b = 0; b < 2; ++b)
#pragma unroll
                for (int m = 0; m < 4; ++m)
#pragma unroll
                    for (int n = 0; n < 2; ++n) acc[a][b][m][n] = (f32x4){0.f, 0.f, 0.f, 0.f};
        cur = nxt; cA = nA; cB = nB; ++ui;
        if constexpr (ALIGN_EPI) { if (wr == 1) PG8_BAR; }
    }
    PG8_WAIT_V(0);
    if constexpr (!ALIGN_EPI) { if (wr == 0) PG8_BAR; }
    PG8_BAR;
    if constexpr (Epi::AFTER_DRAIN) { E.fused(acc, cur, wr, wc, fr, fq, lds, wid, lane); S.done(cur); }
#undef PG8_SA
#undef PG8_SB
#undef PG8_STAGE
#undef PG8_LDA
#undef PG8_LDB
#undef PG8_MMA
#undef PG8_WAIT_V
#undef PG8_WAIT_L
#undef PG8_BAR
#undef PG8_SCHED
}
}
namespace pg8 {
struct EpiRes {
    static constexpr bool PERM = false, AFTER_DRAIN = false;
    const float* res; float* out; int ldc; const float* gate; int gate_stride; int rows_per_batch;
    __device__ __forceinline__ void operator()(const f32x4 (&acc)[2][2][4][2], const Unit& u, int wr, int wc, int fr, int fq) const {
        const int row0 = u.pm * BM + wr * 64 + fr, col0 = u.pn * BM + wc * 32 + 4 * fq;
        const float* gp = gate + (size_t)((u.pm * BM) / rows_per_batch) * gate_stride + col0;
        f32x4 gv[2][2];
#pragma unroll
        for (int bj = 0; bj < 2; ++bj)
#pragma unroll
            for (int n = 0; n < 2; ++n) gv[bj][n] = *(const f32x4*)(gp + bj * HALF + n * 16);
#pragma unroll
        for (int ai = 0; ai < 2; ++ai)
#pragma unroll
            for (int m = 0; m < 4; ++m) { const size_t off = (size_t)(row0 + ai * HALF + m * 16) * ldc + col0;
#pragma unroll
                for (int bj = 0; bj < 2; ++bj)
#pragma unroll
                    for (int n = 0; n < 2; ++n) { const f32x4 r = *(const f32x4*)(res + off + bj * HALF + n * 16); *(f32x4*)(out + off + bj * HALF + n * 16) = r + gv[bj][n] * acc[ai][bj][m][n]; }
                asm volatile("" ::: "memory"); }
    }
};
template <class TI, class TO> struct EpiRes2 {
    static constexpr bool PERM = true, AFTER_DRAIN = false;
    const TI* res; TO* out; int ldc; const float* gate; int gate_stride; int rows_per_batch;
    __device__ __forceinline__ void operator()(const f32x4 (&acc)[2][2][4][2], const Unit& u, int wr, int wc, int fr, int fq) const {
        const int row0 = u.pm * BM + wr * 64 + fr, col0 = u.pn * BM + wc * 32 + 8 * fq;
        const float* gp = gate + (size_t)((u.pm * BM) / rows_per_batch) * gate_stride + col0;
        f32x4 gv[2][2];
#pragma unroll
        for (int bj = 0; bj < 2; ++bj)
#pragma unroll
            for (int n = 0; n < 2; ++n) gv[bj][n] = *(const f32x4*)(gp + bj * HALF + 4 * n);
#pragma unroll
        for (int ai = 0; ai < 2; ++ai)
#pragma unroll
            for (int m = 0; m < 4; ++m) { const size_t off = (size_t)(row0 + ai * HALF + m * 16) * ldc + col0;
#pragma unroll
                for (int bj = 0; bj < 2; ++bj) { f32x4 r0, r1;
                    if constexpr (sizeof(TI) == 4) { r0 = *(const f32x4*)((const float*)res + off + bj * HALF); r1 = *(const f32x4*)((const float*)res + off + bj * HALF + 4); }
                    else { const u32x4 w = *(const u32x4*)((const bf16_t*)res + off + bj * HALF);
                        r0 = (f32x4){__uint_as_float(w.x << 16), __uint_as_float(w.x & 0xffff0000u), __uint_as_float(w.y << 16), __uint_as_float(w.y & 0xffff0000u)};
                        r1 = (f32x4){__uint_as_float(w.z << 16), __uint_as_float(w.z & 0xffff0000u), __uint_as_float(w.w << 16), __uint_as_float(w.w & 0xffff0000u)}; }
                    const f32x4 o0 = r0 + gv[bj][0] * acc[ai][bj][m][0], o1 = r1 + gv[bj][1] * acc[ai][bj][m][1];
                    if constexpr (sizeof(TO) == 4) { *(f32x4*)((float*)out + off + bj * HALF) = o0; *(f32x4*)((float*)out + off + bj * HALF + 4) = o1; }
                    else { u32x4 w; w.x = cvt_pk_bf16(o0[0], o0[1]); w.y = cvt_pk_bf16(o0[2], o0[3]); w.z = cvt_pk_bf16(o1[0], o1[1]); w.w = cvt_pk_bf16(o1[2], o1[3]); *(u32x4*)((bf16_t*)out + off + bj * HALF) = w; } }
                asm volatile("" ::: "memory"); }
    }
};
struct EpiSwiGLU {
    static constexpr bool PERM = true, AFTER_DRAIN = false;
    bf16_t* O; int ldc;
    __device__ __forceinline__ static float act(float g, float u) { return g * __builtin_amdgcn_rcpf(1.0f + __builtin_amdgcn_exp2f(g * -1.4426950408889634f)) * u; }
    __device__ __forceinline__ void operator()(const f32x4 (&acc)[2][2][4][2], const Unit& u, int wr, int wc, int fr, int fq) const {
        const int row0 = u.pm * BM + wr * 64 + fr, col0 = u.pn * HALF + wc * 32 + 8 * fq;
#pragma unroll
        for (int ai = 0; ai < 2; ++ai)
#pragma unroll
            for (int m = 0; m < 4; ++m) { bf16_t* rowp = O + (size_t)(row0 + ai * HALF + m * 16) * ldc + col0;
                const f32x4 g0 = acc[ai][0][m][0], g1 = acc[ai][0][m][1], u0 = acc[ai][1][m][0], u1 = acc[ai][1][m][1];
                u32x4 w; w.x = cvt_pk_bf16(act(g0[0], u0[0]), act(g0[1], u0[1])); w.y = cvt_pk_bf16(act(g0[2], u0[2]), act(g0[3], u0[3]));
                w.z = cvt_pk_bf16(act(g1[0], u1[0]), act(g1[1], u1[1])); w.w = cvt_pk_bf16(act(g1[2], u1[2]), act(g1[3], u1[3]));
                *(u32x4*)rowp = w; }
    }
};
struct EpiQKV {
    static constexpr bool PERM = true, AFTER_DRAIN = false;
    bf16_t* O; size_t tensor_stride; int seq, nheads;
    __device__ __forceinline__ void operator()(const f32x4 (&acc)[2][2][4][2], const Unit& u, int wr, int wc, int fr, int fq) const {
        const int row0 = u.pm * BM + wr * 64 + fr; const int colt = u.pn * BM; const int t = colt / (nheads * 128), head0 = (colt - t * nheads * 128) >> 7;
        const int b = (u.pm * BM) / seq, s0 = row0 - b * seq;
        bf16_t* base = O + (size_t)t * tensor_stride + ((size_t)(b * nheads + head0) * seq + s0) * 128 + wc * 32 + 8 * fq;
#pragma unroll
        for (int ai = 0; ai < 2; ++ai)
#pragma unroll
            for (int m = 0; m < 4; ++m) {
#pragma unroll
                for (int bj = 0; bj < 2; ++bj) { const f32x4 v0 = acc[ai][bj][m][0], v1 = acc[ai][bj][m][1];
                    u32x4 w; w.x = cvt_pk_bf16(v0[0], v0[1]); w.y = cvt_pk_bf16(v0[2], v0[3]); w.z = cvt_pk_bf16(v1[0], v1[1]); w.w = cvt_pk_bf16(v1[2], v1[3]);
                    *(u32x4*)(base + ((size_t)bj * seq + ai * HALF + m * 16) * 128) = w; } }
    }
};
}
#ifndef PG8_SP2
#define PG8_SP2 true
#endif
#ifndef PG8_ALIGN
#define PG8_ALIGN true
#endif
namespace fox {
constexpr int D = 128, PITCH = 128, OPITCH = 2048;
constexpr float SCALE = 0.08838834764831845f;
constexpr float THR = 8.f;
constexpr bool WSKIP = false;
constexpr int NW = 8, QBLK = 32, KVBLK = 64, QB = NW * QBLK;
constexpr int SHM_V = KVBLK * D * 2, SHM_K = KVBLK * D * 2;
constexpr int LDS_BYTES = 2 * SHM_V + 2 * SHM_K + NW * 64 * 4 + 2 * 64 * 4;
using bf16 = unsigned short;
typedef short bf16x8 __attribute__((ext_vector_type(8)));
typedef short s16x4 __attribute__((ext_vector_type(4)));
typedef float f32x16 __attribute__((ext_vector_type(16)));
typedef float f32x4 __attribute__((ext_vector_type(4)));
typedef unsigned u32x4 __attribute__((ext_vector_type(4)));
template <class A, class Bt> struct same_t { static constexpr bool v = false; };
template <class A> struct same_t<A, A> { static constexpr bool v = true; };

#define KSWZ(row, colB) ((row) * 256 + ((colB) ^ (((row) & 7) << 4)))
#define SBAR() __builtin_amdgcn_sched_barrier(0)
__device__ __forceinline__ int v_st(int k, int c) { const int kk = (k & ~0xC) | ((k & 4) << 1) | ((k & 8) >> 1); return ((kk >> 3) * 4 + (c >> 5)) * 512 + ((kk & 7) * 32 + (c & 31)) * 2; }
__device__ __forceinline__ int v_rd_base(int lane) { return ((lane & 3) << 3) | (((lane >> 2) & 3) << 6) | (((lane >> 4) & 1) << 5) | (((lane >> 5) & 1) << 8); }
constexpr int v_rd_off(int d0, int ks, int half) { return d0 * 512 + ks * 4096 + half * 2048; }
__device__ __forceinline__ int crow(int r, int hi) { return (r & 3) + 8 * (r >> 2) + 4 * hi; }
__device__ __forceinline__ unsigned cvtpk(float lo, float hi) {
    unsigned r; asm volatile("v_cvt_pk_bf16_f32 %0, %1, %2" : "=v"(r) : "v"(lo), "v"(hi)); return r;
}
__device__ __forceinline__ bf16x8 pack8(f32x4 a, f32x4 b) {
    u32x4 w = {cvtpk(a[0], a[1]), cvtpk(a[2], a[3]), cvtpk(b[0], b[1]), cvtpk(b[2], b[3])};
    return *reinterpret_cast<bf16x8*>(&w);
}
template <class T> __device__ __forceinline__ bf16x8 load8(const T* p) {
    if constexpr (same_t<T, float>::v) { return pack8(*(const f32x4*)p, *(const f32x4*)(p + 4)); }
    else { return *reinterpret_cast<const bf16x8*>(p); }
}
__device__ __forceinline__ void mask_tile(f32x16& p0, f32x16& p1, int dq, unsigned W) {
    const float NEG = -__builtin_inff();
#pragma unroll
    for (int r = 0; r < 16; ++r) {
        const int c = (r & 3) + 8 * (r >> 2);
        if ((unsigned)(dq - c) >= W) p0[r] = NEG;
        if ((unsigned)(dq - c - 32) >= W) p1[r] = NEG;
    }
}
__device__ __forceinline__ void partialSM(f32x16& p0, f32x16& p1, float& m_reg, float& mn, float& alpha) {
    float pmax = p0[0]; for (int r = 1; r < 16; ++r) pmax = fmaxf(pmax, p0[r]); for (int r = 0; r < 16; ++r) pmax = fmaxf(pmax, p1[r]);
    { auto rr = __builtin_amdgcn_permlane32_swap(__float_as_uint(pmax), __float_as_uint(pmax), false, false);
      pmax = fmaxf(__uint_as_float(rr[0]), __uint_as_float(rr[1])); }
    constexpr float C2 = 1.4426950408889634f * SCALE;
    if (__builtin_expect(__all((pmax - m_reg) * SCALE <= THR), 1)) { mn = m_reg; alpha = 1.f; }
    else { mn = fmaxf(m_reg, pmax); alpha = __builtin_amdgcn_exp2f((m_reg - mn) * C2); m_reg = mn; }
    const float mnL = -mn * C2;
    for (int r = 0; r < 16; ++r) p0[r] = fmaf(p0[r], C2, mnL); for (int r = 0; r < 16; ++r) p1[r] = fmaf(p1[r], C2, mnL);
    for (int r = 0; r < 16; ++r) p0[r] = __builtin_amdgcn_exp2f(p0[r]);
}
__device__ __forceinline__ void finishSM(f32x16& p0, f32x16& p1, float alpha, float& l_reg, bf16x8& pa0, bf16x8& pa1, bf16x8& pa2, bf16x8& pa3) {
    for (int r = 0; r < 16; ++r) p1[r] = __builtin_amdgcn_exp2f(p1[r]);
    float ps = 0; for (int r = 0; r < 16; ++r) ps += p0[r]; for (int r = 0; r < 16; ++r) ps += p1[r];
    { auto rr = __builtin_amdgcn_permlane32_swap(__float_as_uint(ps), __float_as_uint(ps), false, false);
      ps = __uint_as_float(rr[0]) + __uint_as_float(rr[1]); }
    l_reg = l_reg * alpha + ps;
#define PK4(P, B_, OUT) do { unsigned a0 = cvtpk(P[B_+0], P[B_+1]), a1 = cvtpk(P[B_+2], P[B_+3]);                          \
        unsigned b0 = cvtpk(P[B_+4], P[B_+5]), b1 = cvtpk(P[B_+6], P[B_+7]);                                             \
        auto r0 = __builtin_amdgcn_permlane32_swap(a0, b0, false, false); auto r1 = __builtin_amdgcn_permlane32_swap(a1, b1, false, false); \
        u32x4 w = {r0[0], r1[0], r0[1], r1[1]}; OUT = *reinterpret_cast<bf16x8*>(&w); } while (0)
    PK4(p0, 0, pa0); PK4(p0, 8, pa1); PK4(p1, 0, pa2); PK4(p1, 8, pa3);
#undef PK4
}
template <int KB, bool SK, bool NB = false>
__device__ __forceinline__ void qkt(f32x16& p0, f32x16& p1, const char* K_lds, int r32, int hi, const bf16x8* qr, bool act, const float* g_lds, float gt) {
    if (SK && !act) { const float NEG = -__builtin_inff();
#pragma unroll
        for (int r = 0; r < 16; ++r) { p0[r] = NEG; p1[r] = NEG; } return; }
    if constexpr (NB) { p0 = f32x16{}; p1 = f32x16{}; } else
    { const float* gl = g_lds + KB * 64 + 4 * hi;
#pragma unroll
      for (int g4 = 0; g4 < 4; ++g4) { const f32x4 a = *(const f32x4*)(gl + 8 * g4), b = *(const f32x4*)(gl + 32 + 8 * g4);
#pragma unroll
        for (int e = 0; e < 4; ++e) { p0[4 * g4 + e] = a[e]; p1[4 * g4 + e] = b[e]; } } }
    const char* kb[4];
#pragma unroll
    for (int dd = 0; dd < 4; ++dd) kb[dd] = K_lds + KB * SHM_K + KSWZ(r32, (dd * 16 + hi * 8) * 2);
#pragma unroll
    for (int d0 = 0; d0 < 8; ++d0) { const char* a = kb[d0 & 3] + (d0 >> 2) * 128;
        bf16x8 b0 = *reinterpret_cast<const bf16x8*>(a);
        bf16x8 b1 = *reinterpret_cast<const bf16x8*>(a + 32 * 256);
        p0 = __builtin_amdgcn_mfma_f32_32x32x16_bf16(b0, qr[d0], p0, 0, 0, 0);
        p1 = __builtin_amdgcn_mfma_f32_32x32x16_bf16(b1, qr[d0], p1, 0, 0, 0); }
}
template <int VB, bool SK>
__device__ __forceinline__ void pv_tile(f32x16* o, int vb0, bf16x8 pa0, bf16x8 pa1, bf16x8 pa2, bf16x8 pa3, bool act) {
    if (SK && !act) return;
#define TRRD(dst, off) asm volatile("ds_read_b64_tr_b16 %0, %1 offset:%2" : "=&v"(dst) : "v"(vb0), "i"(off) : "memory")
#define PV_D0(d0) do { s16x4 l0, l1, l2, l3, h0, h1, h2, h3; constexpr int b_ = VB * SHM_V + v_rd_off(d0, 0, 0);     \
        TRRD(l0, b_); TRRD(h0, b_ + 2048); TRRD(l1, b_ + 4096); TRRD(h1, b_ + 6144); TRRD(l2, b_ + 8192); TRRD(h2, b_ + 10240); TRRD(l3, b_ + 12288); TRRD(h3, b_ + 14336); \
        asm volatile("s_waitcnt lgkmcnt(0)" ::: "memory"); SBAR();                 \
        o[d0] = __builtin_amdgcn_mfma_f32_32x32x16_bf16(pa0, (bf16x8){l0[0], l0[1], l0[2], l0[3], h0[0], h0[1], h0[2], h0[3]}, o[d0], 0, 0, 0);   \
        o[d0] = __builtin_amdgcn_mfma_f32_32x32x16_bf16(pa1, (bf16x8){l1[0], l1[1], l1[2], l1[3], h1[0], h1[1], h1[2], h1[3]}, o[d0], 0, 0, 0);   \
        o[d0] = __builtin_amdgcn_mfma_f32_32x32x16_bf16(pa2, (bf16x8){l2[0], l2[1], l2[2], l2[3], h2[0], h2[1], h2[2], h2[3]}, o[d0], 0, 0, 0);   \
        o[d0] = __builtin_amdgcn_mfma_f32_32x32x16_bf16(pa3, (bf16x8){l3[0], l3[1], l3[2], l3[3], h3[0], h3[1], h3[2], h3[3]}, o[d0], 0, 0, 0); } while (0)
    PV_D0(0); PV_D0(1); PV_D0(2); PV_D0(3);
#undef PV_D0
#undef TRRD
}

template <class TIn, class TOut> struct BlockRef { const TIn* Q; const TIn* K; const TIn* V; TOut* O; const float* G; int P0; };
template <class TIn> struct Seam {
    bf16x8 qr[8];
    bf16x8 st_v0, st_v1, st_k0, st_k1; f32x4 sf0, sf1, sf2, sf3; float st_g, gt;
    f32x4 tq[16];
};
__device__ __forceinline__ int swa_jlo(int P0, int W) { const int lowk = P0 - W + 1; return lowk > 0 ? lowk / KVBLK : 0; }
#define ROW(p, k0, rr) ((p) + (size_t)((k0) + (rr)) * PITCH + sc)
#define VMW() asm volatile("s_waitcnt vmcnt(0)" ::: "memory")
#define VMWN(n) asm volatile("s_waitcnt vmcnt(%0)" :: "i"(n) : "memory")
#define SLOAD_H(Kp, Vp, Gp, k0) do { const char* kb_ = (const char*)(Kp) + (size_t)(k0) * (PITCH * 2); const char* vb_ = (const char*)(Vp) + (size_t)(k0) * (PITCH * 2); const unsigned vo_ = (unsigned)tid * 16u; \
                         if (wid == 0) S.st_g = *(const float*)((const char*)((Gp) + (k0)) + (vo_ >> 2));                                                    \
                         S.st_v0 = *(const bf16x8*)(vb_ + vo_); S.st_v1 = *(const bf16x8*)(vb_ + 8192 + vo_);                                                \
                         S.st_k0 = *(const bf16x8*)(kb_ + vo_); S.st_k1 = *(const bf16x8*)(kb_ + 8192 + vo_); } while (0)
#define SWRITE_HK(bf) do { if (wid == 0) ((float*)(K_lds + 2 * SHM_K + NW * 256))[(bf) * 64 + lane] = -S.st_g; *(bf16x8*)(K_lds + (bf) * SHM_K + kws) = S.st_k0; *(bf16x8*)(K_lds + (bf) * SHM_K + kws + 32 * 256) = S.st_k1; } while (0)
#define SWRITE_HV(bf) do { *(bf16x8*)(V_lds + (bf) * SHM_V + vst0) = S.st_v0; *(bf16x8*)(V_lds + (bf) * SHM_V + vst1) = S.st_v1; } while (0)
#define SWRITE_H(bf) do { SWRITE_HV(bf); SWRITE_HK(bf); } while (0)
#define SLOAD_F(p, k0) do { S.sf0 = *(const f32x4*)ROW(p, k0, sr); S.sf1 = *(const f32x4*)(ROW(p, k0, sr) + 4);                \
                            S.sf2 = *(const f32x4*)ROW(p, k0, 32 + sr); S.sf3 = *(const f32x4*)(ROW(p, k0, 32 + sr) + 4); } while (0)
#define SWRITE_KF(bf) do { *(bf16x8*)(K_lds + (bf) * SHM_K + kws) = pack8(S.sf0, S.sf1); *(bf16x8*)(K_lds + (bf) * SHM_K + kws + 32 * 256) = pack8(S.sf2, S.sf3); } while (0)
#define SWRITE_VF(bf) do { *(bf16x8*)(V_lds + (bf) * SHM_V + vst0) = pack8(S.sf0, S.sf1); *(bf16x8*)(V_lds + (bf) * SHM_V + vst1) = pack8(S.sf2, S.sf3); } while (0)
template <class TIn, class TOut>
__device__ __forceinline__ void causal_swa_prime(const BlockRef<TIn, TOut>& cur, int W, char* lds, Seam<TIn>& S) {
    constexpr bool F32 = same_t<TIn, float>::v;
    int tid_ = threadIdx.x; asm volatile("" : "+v"(tid_)); const int tid = tid_, wid = __builtin_amdgcn_readfirstlane(tid >> 6), lane = tid & 63, r32 = lane & 31, hi = lane >> 5;
    const int sr = tid >> 4, sc = (tid & 15) * 8, kws = KSWZ(sr, sc * 2); char* K_lds = lds + 2 * SHM_V;
    const int kb0 = ((cur.P0 + QB - 1) / KVBLK) * KVBLK;
    for (int d0 = 0; d0 < 8; ++d0) S.qr[d0] = load8<TIn>(cur.Q + (size_t)(wid * QBLK + r32) * PITCH + d0 * 16 + hi * 8);
    S.gt = 0.f;
    if constexpr (F32) { SLOAD_F((const float*)cur.K, kb0); VMW(); SWRITE_KF(0); SBAR(); SLOAD_F((const float*)cur.V, kb0); }
    else { SLOAD_H(cur.K, cur.V, cur.G, kb0); VMW(); SWRITE_HK(0); }
    __syncthreads();
}
template <class TIn, class TOut, bool NB = false>
__device__ __forceinline__ void causal_swa_block(const BlockRef<TIn, TOut>& cur, const BlockRef<TIn, TOut>& nxt, int skv, int W, char* lds, Seam<TIn>& S) {
    constexpr bool F32 = same_t<TIn, float>::v;
    int tid_ = threadIdx.x; asm volatile("" : "+v"(tid_)); const int tid = tid_, wid = __builtin_amdgcn_readfirstlane(tid >> 6), lane = tid & 63, r32 = lane & 31, hi = lane >> 5;
    const int j_lo = swa_jlo(cur.P0, W);
    int j_hi = (cur.P0 + QB - 1) / KVBLK + 1; if (j_hi > skv / KVBLK) j_hi = skv / KVBLK;
    const int NT = j_hi - j_lo;
    const int kbn = ((nxt.P0 + QB - 1) / KVBLK) * KVBLK;
    const int qlo = cur.P0 + wid * QBLK, qm = qlo + r32 - 4 * hi;
    char* V_lds = lds; char* K_lds = lds + 2 * SHM_V;
    float* ws = (float*)(lds + 2 * SHM_V + 2 * SHM_K) + wid * 64; float* li_l = ws, * al_l = ws + 32;
    float m_reg = -1e30f, l_reg = 0; f32x16 o[4] = {};
    const int sr = tid >> 4, sc = (tid & 15) * 8, vst0 = v_st(sr, sc), vst1 = v_st(32 + sr, sc), kws = KSWZ(sr, sc * 2);
    const int vb0 = (int)(uintptr_t)V_lds + v_rd_base(lane);
    const TIn* Kh = cur.K; const TIn* Vh = cur.V; const float* Gh = cur.G; const float* g_lds = (const float*)(K_lds + 2 * SHM_K + NW * 256);
#define RESC(a) do { if (__any((a) < 1.f)) { if (hi == 0) al_l[r32] = (a); asm volatile("s_waitcnt lgkmcnt(0)" ::: "memory");              \
                     for (int d_ = 0; d_ < 4; ++d_) for (int r = 0; r < 16; ++r) o[d_][r] *= al_l[crow(r, hi)]; } } while (0)
#define KBASE(t) ((j_hi - 1 - (t)) * KVBLK)
#define ACT(t) (KBASE(t) <= qlo + QBLK - 1 && KBASE(t) + KVBLK - 1 >= qlo - W + 1)
#define MASKT(P0_, P1_, t) do { const int kb_ = KBASE(t); if ((!SK || ACT(t)) && (kb_ + KVBLK - 1 > qlo || kb_ <= qlo + QBLK - 1 - W)) mask_tile(P0_, P1_, qm - kb_, (unsigned)W); } while (0)
    constexpr int NQL = F32 ? 16 : 8;
    constexpr bool SK = WSKIP && !F32;
#define SEAM_K0() do { VMWN(NQL); if constexpr (F32) { SWRITE_KF(0); SBAR(); SLOAD_F((const float*)nxt.V, kbn); } else { SWRITE_HK(0); } SBAR(); } while (0)
    f32x16 pA0, pA1, pB0, pB1; float mnA, mnB, alA, alB; bf16x8 pa0, pa1, pa2, pa3;
    if constexpr (F32) { VMW(); SWRITE_VF(0); SBAR(); } else { SWRITE_HV(0); SBAR(); }
    if (NT > 1) { if constexpr (F32) SLOAD_F((const float*)Kh, KBASE(1)); else SLOAD_H(Kh, Vh, Gh, KBASE(1)); }
    SBAR(); qkt<0, SK, NB>(pA0, pA1, K_lds, r32, hi, S.qr, ACT(0), g_lds, S.gt);
    if constexpr (F32) { if (NT > 1) { VMW(); SWRITE_KF(1); SBAR(); SLOAD_F((const float*)Vh, KBASE(1)); } }
    MASKT(pA0, pA1, 0); partialSM(pA0, pA1, m_reg, mnA, alA);
    if (NT > 1) { VMW(); if constexpr (F32) { SWRITE_VF(1); SBAR(); if (NT > 2) SLOAD_F((const float*)Kh, KBASE(2)); } else SWRITE_H(1); }
    __syncthreads();
#define HALF_STEP(PX0, PX1, mnX, alX, PY0, PY1, alY, t, KB, VB, SB) do {                                                      \
        SBAR(); qkt<KB, SK, NB>(PX0, PX1, K_lds, r32, hi, S.qr, ACT(t), g_lds, S.gt);                                             \
        finishSM(PY0, PY1, alY, l_reg, pa0, pa1, pa2, pa3); SBAR();                                                           \
        if ((t) + 1 < NT) { if constexpr (F32) { VMW(); SWRITE_KF(SB); SBAR(); SLOAD_F((const float*)Vh, KBASE((t) + 1)); }  \
                            else { SLOAD_H(Kh, Vh, Gh, KBASE((t) + 1)); } SBAR(); }                                               \
        pv_tile<VB, SK>(o, vb0, pa0, pa1, pa2, pa3, ACT((t) - 1)); MASKT(PX0, PX1, (t)); partialSM(PX0, PX1, m_reg, mnX, alX);                                        \
        __syncthreads();                                                                                                      \
        if ((t) + 1 < NT) { VMW(); if constexpr (F32) { SWRITE_VF(SB); SBAR(); if ((t) + 2 < NT) SLOAD_F((const float*)Kh, KBASE((t) + 2)); } \
                            else { SWRITE_H(SB); } }                                                                          \
        RESC(alX); __syncthreads(); } while (0)
    for (int t = 1; t + 1 < NT; t += 2) {
        HALF_STEP(pB0, pB1, mnB, alB, pA0, pA1, alA, t, 1, 0, 0);
        HALF_STEP(pA0, pA1, mnA, alA, pB0, pB1, alB, t + 1, 0, 1, 1);
    }
    const bool even = (NT & 1) == 0;
    if (even) { SBAR(); qkt<1, SK, NB>(pB0, pB1, K_lds, r32, hi, S.qr, ACT(NT - 1), g_lds, S.gt); SBAR(); }
#define QROW(e) (nxt.Q + (size_t)(wid * QBLK + r32) * PITCH + ((e) >> 1) * 16 + hi * 8 + ((e) & 1) * 4)
    if constexpr (F32) { SLOAD_F((const float*)nxt.K, kbn); SBAR();
#pragma unroll
        for (int e = 0; e < 8; ++e) S.tq[e] = *(const f32x4*)QROW(e); }
    else { SLOAD_H(nxt.K, nxt.V, nxt.G, kbn); SBAR();
#pragma unroll
        for (int d0 = 0; d0 < 8; ++d0) S.qr[d0] = load8<TIn>(nxt.Q + (size_t)(wid * QBLK + r32) * PITCH + d0 * 16 + hi * 8); }
    SBAR();
    finishSM(pA0, pA1, alA, l_reg, pa0, pa1, pa2, pa3); SBAR();
    if constexpr (F32) {
#pragma unroll
        for (int e = 8; e < 16; ++e) S.tq[e] = *(const f32x4*)QROW(e); SBAR(); }
#undef QROW
    pv_tile<0, SK>(o, vb0, pa0, pa1, pa2, pa3, ACT(even ? NT - 2 : NT - 1));
    if (even) { MASKT(pB0, pB1, NT - 1); partialSM(pB0, pB1, m_reg, mnB, alB); __syncthreads(); RESC(alB);
        finishSM(pB0, pB1, alB, l_reg, pa0, pa1, pa2, pa3); SBAR(); pv_tile<1, SK>(o, vb0, pa0, pa1, pa2, pa3, ACT(NT - 1)); }
    SBAR(); SEAM_K0();
    if (hi == 0) li_l[r32] = l_reg; asm volatile("s_waitcnt lgkmcnt(0)" ::: "memory");
    float rli[16];
#pragma unroll
    for (int r = 0; r < 16; ++r) rli[r] = __builtin_amdgcn_rcpf(li_l[crow(r, hi)]);
    TOut* Ow = cur.O + (size_t)(wid * QBLK) * OPITCH;
#pragma unroll
    for (int r = 0; r < 16; ++r) { const int orow = crow(r, hi);
#pragma unroll
        for (int d0 = 0; d0 < 4; ++d0) { const float v = o[d0][r] * rli[r];
            if constexpr (same_t<TOut, float>::v) { Ow[(size_t)orow * OPITCH + d0 * 32 + r32] = v; }
            else { const float vn = __shfl_xor(v, 1);
                   if ((r32 & 1) == 0) *(unsigned*)(Ow + (size_t)orow * OPITCH + d0 * 32 + r32) = cvtpk(v, vn); } } }
    if constexpr (F32) {
#pragma unroll
        for (int d0 = 0; d0 < 8; ++d0) S.qr[d0] = pack8(S.tq[2 * d0], S.tq[2 * d0 + 1]); }
    __syncthreads();
#undef RESC
#undef KBASE
#undef ACT
#undef MASKT
#undef SEAM_K0
#undef HALF_STEP
}
#undef ROW
#undef VMW
#undef VMWN
#undef SLOAD_H
#undef SWRITE_HK
#undef SWRITE_HV
#undef SWRITE_H
#undef SLOAD_F
#undef SWRITE_KF
#undef SWRITE_VF

}
#ifndef MK_ONE_LAUNCH
#define MK_ONE_LAUNCH 1
#endif
#define LAS __attribute__((address_space(3)))
typedef unsigned short bf16;
typedef float f32x4 __attribute__((ext_vector_type(4)));
typedef unsigned u32x4 __attribute__((ext_vector_type(4)));
typedef unsigned u32x2 __attribute__((ext_vector_type(2)));
typedef short bf16x8 __attribute__((ext_vector_type(8)));

constexpr int BATCH = 4, SEQ = 4096, DM = 2048, M = BATCH * SEQ, FFH = 5632, NMOD = 6, MODS = NMOD * DM, NBIN = 3 * DM + 16, NH = 16;
constexpr float EPS = 1e-6f;
constexpr int NWAVES = 8, NTHR = 512;
constexpr int LDS_BYTES = 153600;
constexpr int NPHASE = 16;

constexpr size_t MiB = 1u << 20;
constexpr size_t WS_CTL = 0, WS_MOD = 1 * MiB, ZERO_BYTES = 2 * MiB;
constexpr size_t WS_LOGF = 2 * MiB, WS_G = 3 * MiB, WS_WM = 4 * MiB;
constexpr size_t WS_WAIN = 8 * MiB, WS_WAOUT = 24 * MiB, WS_WBIN = 32 * MiB, WS_WBOUT = 56 * MiB, WS_WGU = 64 * MiB, WS_WDN = 152 * MiB;
constexpr size_t WS_H = 196 * MiB;
constexpr size_t WS_R1 = 260 * MiB;
constexpr size_t WS_RA = 452 * MiB;
constexpr size_t WS_X = 628 * MiB, WS_END = 756 * MiB;
constexpr size_t SZ_ACT = (size_t)M * DM * 2;

struct Args { const float* in[20]; float* out; unsigned char* ws; int ph_lo, ph_hi; };

#define LDS_WAIT() asm volatile("s_waitcnt lgkmcnt(0)" ::: "memory")
__device__ __forceinline__ unsigned pk_bf16(float lo, float hi) { unsigned r; asm volatile("v_cvt_pk_bf16_f32 %0, %1, %2" : "=v"(r) : "v"(lo), "v"(hi)); return r; }
__device__ __forceinline__ float bf_lo(unsigned w) { return __uint_as_float(w << 16); }
__device__ __forceinline__ float bf_hi(unsigned w) { return __uint_as_float(w & 0xffff0000u); }
__device__ __forceinline__ float wave_sum(float v) {
#pragma unroll
    for (int o = 1; o < 64; o <<= 1) v += __shfl_xor(v, o);
    return v;
}

typedef __attribute__((address_space(1))) unsigned gu32;
constexpr int CW_BAR = 4096;
constexpr int MISC_OFF = LDS_BYTES - 64;
#define XB_TMO      128
#define XB_XCNT(j)  (256  + 64 * (j))
#define XB_XSUB(j)  (1280 + 64 * (j))
#define XB_XGEN(j)  (2304 + 64 * (j))
#define XB_TOP      3328
#define XB_TOPGEN   3392
#define XCD_BAR_WORDS 3456
#define XB_SPIN_CAP (1u << 18)

__device__ __forceinline__ unsigned xb_ld(unsigned* p)              { return __hip_atomic_load(p, __ATOMIC_RELAXED, __HIP_MEMORY_SCOPE_AGENT); }
__device__ __forceinline__ unsigned xb_add(unsigned* p, unsigned v) { return __hip_atomic_fetch_add(p, v, __ATOMIC_RELAXED, __HIP_MEMORY_SCOPE_AGENT); }
__device__ __forceinline__ unsigned xb_xcc_id() { return (unsigned)__builtin_amdgcn_s_getreg((3 << 11) | 20) & 0xFu; }
#define XB_SPIN(cond, bar) do { unsigned _sp = 0; while (cond) { __builtin_amdgcn_s_sleep(1); \
    if ((++_sp & 255u) == 0u) { if (xb_ld(&(bar)[XB_TMO])) break; if (_sp > XB_SPIN_CAP) { atomicAdd(&(bar)[XB_TMO], 1u); break; } } } } while (0)

struct XcdBarrier {
    unsigned* bar; unsigned x;
    volatile LAS unsigned* st;
};

__device__ __forceinline__ XcdBarrier xcd_barrier_post(unsigned* bar, volatile LAS unsigned* st) {
    XcdBarrier b; b.bar = bar; b.x = xb_xcc_id(); b.st = st;
    if (threadIdx.x == 0) (void)xb_add(&bar[XB_XCNT(b.x)], 1u);
    return b;
}
__device__ __forceinline__ void xcd_barrier_complete(unsigned* bar, unsigned x, unsigned& nloc, unsigned& nx) {
    const unsigned G = gridDim.x * gridDim.y * gridDim.z;
    unsigned sum, cnt, mine, sp = 0u;
    for (;;) {
        sum = 0u; cnt = 0u; mine = 0u;
#pragma unroll
        for (unsigned j = 0; j < 16; ++j) { const unsigned c = xb_ld(&bar[XB_XCNT(j)]); sum += c; cnt += (c > 0u) ? 1u : 0u; mine = (j == x) ? c : mine; }
        if (sum == G) break;
        __builtin_amdgcn_s_sleep(1);
        if ((++sp & 255u) == 0u) { if (xb_ld(&bar[XB_TMO])) break; if (sp > XB_SPIN_CAP) { atomicAdd(&bar[XB_TMO], 1u); break; } }
    }
    nloc = mine > 0u ? mine : 1u; nx = cnt > 0u ? cnt : 1u;
}

__device__ __forceinline__ void xcd_barrier(const XcdBarrier& b) {
    asm volatile("s_waitcnt vmcnt(0)" ::: "memory");
    __syncthreads();
    if (threadIdx.x == 0) {
        unsigned* bar = b.bar;
        __builtin_amdgcn_s_waitcnt(0);
        unsigned nloc = b.st[0], nx = b.st[1];
        if (nloc == 0u) { xcd_barrier_complete(bar, b.x, nloc, nx); b.st[0] = nloc; b.st[1] = nx; }
        const unsigned old = xb_add(&bar[XB_XSUB(b.x)], 1u);
        const unsigned gen = old / nloc;
        if (old + 1u == (gen + 1u) * nloc) {
            __builtin_amdgcn_fence(__ATOMIC_RELEASE, "agent");
            asm volatile("s_waitcnt vmcnt(0)" ::: "memory");
            const unsigned og = xb_add(&bar[XB_TOP], 1u);
            const unsigned tg = og / nx;
            if (og + 1u == (tg + 1u) * nx) xb_add(&bar[XB_TOPGEN], 1u);
            else XB_SPIN(xb_ld(&bar[XB_TOPGEN]) == tg, bar);
            __builtin_amdgcn_fence(__ATOMIC_ACQUIRE, "agent");
            xb_add(&bar[XB_XGEN(b.x)], 1u);
            asm volatile("s_waitcnt vmcnt(0)" ::: "memory");
        } else {
            XB_SPIN(xb_ld(&bar[XB_XGEN(b.x)]) == gen, bar);
            __builtin_amdgcn_fence(__ATOMIC_ACQUIRE, "agent");
            asm volatile("s_waitcnt vmcnt(0)" ::: "memory");
        }
    }
    __syncthreads();
}

__device__ __forceinline__ void transpose_item(const float* __restrict__ W, int ldw, int Kd, bf16* __restrict__ WT, int k0, int n0, int drow0, LAS float* scr, int lane) {
    {   f32x4 v[8];
        const float* wp = W + (size_t)(k0 + (lane >> 3)) * ldw + n0 + (lane & 7) * 4;
#pragma unroll
        for (int i = 0; i < 8; ++i) v[i] = __builtin_nontemporal_load((const f32x4*)(wp + (size_t)(8 * i) * ldw));
#pragma unroll
        for (int i = 0; i < 8; ++i) { LAS float* d = scr + (8 * i + (lane >> 3)) * 33 + (lane & 7) * 4; d[0] = v[i].x; d[1] = v[i].y; d[2] = v[i].z; d[3] = v[i].w; } }
    LDS_WAIT(); asm volatile("" ::: "memory");
    const int c = lane & 7;
#pragma unroll
    for (int j = 0; j < 4; ++j) { const int n = (lane >> 3) + 8 * j; const LAS float* s = scr + (8 * c) * 33 + n;
        u32x4 o; o.x = pk_bf16(s[0 * 33], s[1 * 33]); o.y = pk_bf16(s[2 * 33], s[3 * 33]); o.z = pk_bf16(s[4 * 33], s[5 * 33]); o.w = pk_bf16(s[6 * 33], s[7 * 33]);
        *(u32x4*)(WT + (size_t)(drow0 + n) * Kd + k0 + 8 * c) = o; }
    LDS_WAIT(); asm volatile("" ::: "memory");
}

__device__ __forceinline__ void mod_task(int t, const LAS float* scl, const float* __restrict__ ada_w, const float* __restrict__ ada_b, float* mod, int lane) {
    const int i = t / 1008, rem = t - i * 1008, cg = rem / 168, r2 = rem - cg * 168, ks = r2 >> 3, cc = cg * 8 + (r2 & 7);
    const int k0 = (ks * DM) / 21, k1 = ((ks + 1) * DM) / 21;
    const int col = cc * 256 + lane * 4;
    f32x4 acc[4];
#pragma unroll
    for (int b = 0; b < 4; ++b) acc[b] = (f32x4){0.f, 0.f, 0.f, 0.f};
    const float* wp = ada_w + ((size_t)i * DM) * MODS + col;
#pragma unroll 8
    for (int k = k0; k < k1; ++k) {
        const f32x4 w = *(const f32x4*)(wp + (size_t)k * MODS);
        const f32x4 sv = *(const LAS f32x4*)(scl + 4 * k);
        acc[0] += sv.x * w; acc[1] += sv.y * w; acc[2] += sv.z * w; acc[3] += sv.w * w;
    }
    if (ks == 0) { const f32x4 bv = *(const f32x4*)(ada_b + (size_t)i * MODS + col);
#pragma unroll
        for (int b = 0; b < 4; ++b) acc[b] += bv; }
#pragma unroll
    for (int b = 0; b < 4; ++b) { float* mp = mod + ((size_t)i * BATCH + b) * MODS + col;
        atomicAdd(mp + 0, acc[b][0]); atomicAdd(mp + 1, acc[b][1]); atomicAdd(mp + 2, acc[b][2]); atomicAdd(mp + 3, acc[b][3]); }
}

struct P0Ptrs { const float *a_w_in, *a_w_out, *b_w_in, *b_w_out, *w_gate, *w_up, *w_down, *a_w_s, *c, *ada_w, *ada_b; bf16 *WAin, *WAout, *WBin, *WBout, *Wgu, *Wdn, *Wm; float* mod; };
template <int ONLY = 0>
__device__ __forceinline__ void p0_prologue(LAS unsigned char* lds, const P0Ptrs& P, int vcu, int G, int tid, int wave, int lane) {
    LAS float* scr = (LAS float*)(lds + wave * 16384);
    const int gw = vcu * NWAVES + wave, NGW = G * NWAVES;
    {   LAS float* scl = (LAS float*)lds;
        for (int idx = tid; idx < BATCH * DM; idx += NTHR) { const int k = idx >> 2, b = idx & 3; const float cv = P.c[b * DM + k]; scl[idx] = cv / (1.0f + __expf(-cv)); }
        __syncthreads();
        for (int t = gw; t < 2016; t += NGW) mod_task(t, scl, P.ada_w, P.ada_b, P.mod, lane);
        __syncthreads(); }
    if (ONLY == 1) return;
    for (int idx = gw * 64 + lane; idx < NH * 128 * 128; idx += NGW * 64) { const int tt = (idx >> 7) & 127, s = idx & 127; P.Wm[idx] = (s <= tt) ? (bf16)(pk_bf16(P.a_w_s[idx], 0.f) & 0xffffu) : (bf16)0; }
    constexpr int I_AIN = 32 * 128, I_AOUT = 32 * 64, I_BIN = 32 * 192, I_BOUT = 32 * 64, I_G = 32 * 176, I_D = 88 * 64;
    constexpr int NITEMS = I_AIN + I_AOUT + I_BIN + I_BOUT + 4 * I_G + 2 * I_D;
    for (int it = gw; it < NITEMS; it += NGW) {
        int r = it;
        if (r < I_AIN) { const int kb = r / 128, nb = r % 128; transpose_item(P.a_w_in, 2 * DM, DM, P.WAin, 64 * kb, 32 * nb, 32 * nb, scr, lane); continue; } r -= I_AIN;
        if (r < I_AOUT) { const int kb = r / 64, nb = r % 64; transpose_item(P.a_w_out, DM, DM, P.WAout, 64 * kb, 32 * nb, 32 * nb, scr, lane); continue; } r -= I_AOUT;
        if (r < I_BIN) { const int kb = r / 192, nb = r % 192; transpose_item(P.b_w_in, NBIN, DM, P.WBin, 64 * kb, 32 * nb, 32 * nb, scr, lane); continue; } r -= I_BIN;
        if (r < I_BOUT) { const int kb = r / 64, nb = r % 64; transpose_item(P.b_w_out, DM, DM, P.WBout, 64 * kb, 32 * nb, 32 * nb, scr, lane); continue; } r -= I_BOUT;
        if (r < 4 * I_G) { const int which = r / I_G, rr = r % I_G, layer = which >> 1, isup = which & 1, kb = rr / 176, nb = rr % 176, n0 = 32 * nb;
            const float* W = (isup ? P.w_up : P.w_gate) + (size_t)layer * DM * FFH;
            transpose_item(W, FFH, DM, P.Wgu + (size_t)layer * 2 * FFH * DM, 64 * kb, n0, 256 * (n0 >> 7) + (n0 & 127) + 128 * isup, scr, lane); continue; } r -= 4 * I_G;
        { const int layer = r / I_D, rr = r % I_D, kb = rr / 64, nb = rr % 64;
            transpose_item(P.w_down + (size_t)layer * FFH * DM, DM, FFH, P.Wdn + (size_t)layer * DM * FFH, 64 * kb, 32 * nb, 32 * nb, scr, lane); }
    }
}

constexpr int WTP = DM + 4;
template <int MODE, bool INBF>
__device__ __forceinline__ void norm_phase(LAS unsigned char* lds, const void* __restrict__ xin_, const float* __restrict__ gvec, const float* shift, const float* scale,
                                           bf16* outb, float* outf, const float* __restrict__ wf, const float* __restrict__ bfv, float* logf_out, int tid, int wave, int lane) {
    LAS float* cA = (LAS float*)lds; LAS float* cB = cA + DM; LAS float* wT = (LAS float*)(lds + 16384);
    for (int blk = blockIdx.x; blk < M / 64; blk += gridDim.x) {
        const int b = (blk * 64) / SEQ;
        __syncthreads();
        for (int cidx = tid; cidx < DM; cidx += NTHR) { const float g = gvec[cidx];
            if (MODE != 1) { cA[cidx] = g * (1.0f + scale[(size_t)b * MODS + cidx]); cB[cidx] = shift[(size_t)b * MODS + cidx]; } else { cA[cidx] = g; cB[cidx] = 0.f; } }
        if (MODE == 2 && blk == (int)blockIdx.x) {
            for (int idx = tid; idx < DM * 16; idx += NTHR) { const int k = idx >> 4, hh = idx & 15; wT[hh * WTP + k] = wf[(size_t)k * NBIN + 3 * DM + hh]; } }
        __syncthreads();
        constexpr int RB = (MODE == 2) ? 2 : 1;
        for (int i0 = 0; i0 < 8; i0 += RB) {
            f32x4 v[RB][8];
#pragma unroll
            for (int q = 0; q < RB; ++q) { const int row = blk * 64 + wave + 8 * (i0 + q);
                if (INBF) { const u32x2* xr = (const u32x2*)((const bf16*)xin_ + (size_t)row * DM) + lane;
#pragma unroll
                    for (int j = 0; j < 8; ++j) { const u32x2 w = xr[64 * j]; v[q][j] = (f32x4){bf_lo(w.x), bf_hi(w.x), bf_lo(w.y), bf_hi(w.y)}; }
                } else { const f32x4* xr = (const f32x4*)((const float*)xin_ + (size_t)row * DM) + lane;
#pragma unroll
                    for (int j = 0; j < 8; ++j) v[q][j] = xr[64 * j]; } }
#pragma unroll
            for (int q = 0; q < RB; ++q) { const int row = blk * 64 + wave + 8 * (i0 + q); float ss = 0.f;
#pragma unroll
                for (int j = 0; j < 8; ++j) ss += (v[q][j].x * v[q][j].x + v[q][j].y * v[q][j].y) + (v[q][j].z * v[q][j].z + v[q][j].w * v[q][j].w);
                const float rstd = 1.0f / sqrtf(wave_sum(ss) * (1.0f / DM) + EPS);
#pragma unroll
                for (int j = 0; j < 8; ++j) { const f32x4 a = *(const LAS f32x4*)(cA + 4 * (64 * j + lane)), bb = *(const LAS f32x4*)(cB + 4 * (64 * j + lane)); v[q][j] = (v[q][j] * rstd) * a + bb; }
                if (MODE == 1) { f32x4* o = (f32x4*)(outf + (size_t)row * DM) + lane;
#pragma unroll
                    for (int j = 0; j < 8; ++j) o[64 * j] = v[q][j];
                } else { u32x2* o = (u32x2*)(outb + (size_t)row * DM) + lane;
#pragma unroll
                    for (int j = 0; j < 8; ++j) { u32x2 w; w.x = pk_bf16(v[q][j].x, v[q][j].y); w.y = pk_bf16(v[q][j].z, v[q][j].w); o[64 * j] = w; } } }
            if (MODE == 2) {
                float mine[RB];
#pragma unroll
                for (int q = 0; q < RB; ++q) mine[q] = 0.f;
#pragma unroll 2
                for (int hh = 0; hh < 16; ++hh) { float a[RB];
#pragma unroll
                    for (int q = 0; q < RB; ++q) a[q] = 0.f;
#pragma unroll
                    for (int j = 0; j < 8; ++j) { const f32x4 w = *(const LAS f32x4*)(wT + hh * WTP + 4 * (64 * j + lane));
#pragma unroll
                        for (int q = 0; q < RB; ++q) a[q] += (v[q][j].x * w.x + v[q][j].y * w.y) + (v[q][j].z * w.z + v[q][j].w * w.w); }
#pragma unroll
                    for (int q = 0; q < RB; ++q) { const float s = wave_sum(a[q]); mine[q] = (lane == hh) ? s : mine[q]; } }
#pragma unroll
                for (int q = 0; q < RB; ++q) if (lane < 16) { const int row = blk * 64 + wave + 8 * (i0 + q); const float xx = mine[q] + bfv[lane]; const float lf = fminf(xx, 0.f) - log1pf(expf(-fabsf(xx))); logf_out[(size_t)row * 16 + lane] = lf; }
            }
        }
    }
}

__device__ __forceinline__ void cumsum_phase(LAS unsigned char* lds, const float* logf, float* Gout, int tid, int wave, int lane) {
    LAS float* wt = (LAS float*)lds;
    for (int bh = blockIdx.x; bh < BATCH * NH; bh += gridDim.x) {
        const int b = bh >> 4, h = bh & 15; float v[8]; float run = 0.f;
#pragma unroll
        for (int e = 0; e < 8; ++e) { run += logf[((size_t)b * SEQ + tid * 8 + e) * 16 + h]; v[e] = run; }
        float inc = run;
#pragma unroll
        for (int o = 1; o < 64; o <<= 1) { const float t = __shfl_up(inc, o); if (lane >= o) inc += t; }
        __syncthreads();
        if (lane == 63) wt[wave] = inc;
        __syncthreads();
        float off = inc - run;
#pragma unroll
        for (int w = 0; w < NWAVES; ++w) off += (w < wave) ? wt[w] : 0.f;
        float* gp = Gout + (size_t)bh * SEQ + tid * 8;
#pragma unroll
        for (int e = 0; e < 8; ++e) gp[e] = (off + v[e]) * 11.313708498984761f;
    }
    __syncthreads();
}

constexpr int VTP = 136;
__device__ __forceinline__ void sgu_phase(LAS unsigned char* lds, const bf16* __restrict__ U, const bf16* __restrict__ V, bf16* __restrict__ Y, const bf16* __restrict__ Wm,
                                          const float* __restrict__ ln_g, const float* __restrict__ ln_b, const float* __restrict__ b_s, int tid, int wave, int lane) {
    LAS float* st = (LAS float*)lds; LAS bf16* VT = (LAS bf16*)(lds + 1024);
    for (int unit = blockIdx.x; unit < (M / 128) * 2; unit += gridDim.x) {
        const int chunk = unit >> 1, half = unit & 1, row0 = chunk * 128;
        __syncthreads();
        for (int rb = 0; rb < 16; rb += 4) { u32x4 sw[4][4];
#pragma unroll
            for (int q = 0; q < 4; ++q) { const u32x4* vp = (const u32x4*)(V + (size_t)(row0 + wave * 16 + rb + q) * DM) + lane;
#pragma unroll
                for (int j = 0; j < 4; ++j) sw[q][j] = vp[64 * j]; }
#pragma unroll
            for (int q = 0; q < 4; ++q) { const int rl = wave * 16 + rb + q; float s = 0.f, qq = 0.f;
#pragma unroll
                for (int j = 0; j < 4; ++j) { const u32x4 w = sw[q][j];
                    const float x0 = bf_lo(w.x), x1 = bf_hi(w.x), x2 = bf_lo(w.y), x3 = bf_hi(w.y), x4 = bf_lo(w.z), x5 = bf_hi(w.z), x6 = bf_lo(w.w), x7 = bf_hi(w.w);
                    s += ((x0 + x1) + (x2 + x3)) + ((x4 + x5) + (x6 + x7)); qq += ((x0 * x0 + x1 * x1) + (x2 * x2 + x3 * x3)) + ((x4 * x4 + x5 * x5) + (x6 * x6 + x7 * x7)); }
                s = wave_sum(s); qq = wave_sum(qq); const float mean = s * (1.0f / DM); const float var = fmaxf(qq * (1.0f / DM) - mean * mean, 0.f);
                if (lane == 0) { st[2 * rl] = mean; st[2 * rl + 1] = 1.0f / sqrtf(var + EPS); } } }
        __syncthreads();
        const int srow = wave * 16 + (lane & 15), t0 = wave * 16, nks = (wave >> 1) + 1, tq = t0 + (lane & 15);
        const size_t rowoff = (size_t)(row0 + tq) * DM;
        u32x4 vr[4];
#pragma unroll
        for (int i = 0; i < 4; ++i) vr[i] = *(const u32x4*)(V + (size_t)(row0 + srow) * DM + (half * 8) * 128 + ((lane >> 4) + 4 * i) * 8);
        for (int gi = 0; gi < 8; ++gi) {
            const int g = half * 8 + gi;
            bf16x8 af[4]; u32x2 uw[8];
#pragma unroll
            for (int ks = 0; ks < 4; ++ks) af[ks] = *(const bf16x8*)(Wm + ((size_t)(g * 128 + tq) * 128 + ks * 32 + 8 * (lane >> 4)));
#pragma unroll
            for (int n = 0; n < 8; ++n) uw[n] = *(const u32x2*)(U + rowoff + g * 128 + n * 16 + 4 * (lane >> 4));
            const float bs = b_s[g * 128 + tq];
            {   const float mean = st[2 * srow], rstd = st[2 * srow + 1];
#pragma unroll
                for (int i = 0; i < 4; ++i) { const int cc = (lane >> 4) + 4 * i, col = g * 128 + cc * 8; const u32x4 w = vr[i];
                    const f32x4 g0 = *(const f32x4*)(ln_g + col), g1 = *(const f32x4*)(ln_g + col + 4), b0 = *(const f32x4*)(ln_b + col), b1 = *(const f32x4*)(ln_b + col + 4);
                    LAS bf16* vt = VT + (cc * 8) * VTP + srow;
                    vt[0 * VTP] = (bf16)pk_bf16((bf_lo(w.x) - mean) * rstd * g0.x + b0.x, 0.f); vt[1 * VTP] = (bf16)pk_bf16((bf_hi(w.x) - mean) * rstd * g0.y + b0.y, 0.f);
                    vt[2 * VTP] = (bf16)pk_bf16((bf_lo(w.y) - mean) * rstd * g0.z + b0.z, 0.f); vt[3 * VTP] = (bf16)pk_bf16((bf_hi(w.y) - mean) * rstd * g0.w + b0.w, 0.f);
                    vt[4 * VTP] = (bf16)pk_bf16((bf_lo(w.z) - mean) * rstd * g1.x + b1.x, 0.f); vt[5 * VTP] = (bf16)pk_bf16((bf_hi(w.z) - mean) * rstd * g1.y + b1.y, 0.f);
                    vt[6 * VTP] = (bf16)pk_bf16((bf_lo(w.w) - mean) * rstd * g1.z + b1.z, 0.f); vt[7 * VTP] = (bf16)pk_bf16((bf_hi(w.w) - mean) * rstd * g1.w + b1.w, 0.f); } }
            __syncthreads();
            if (gi + 1 < 8) {
#pragma unroll
                for (int i = 0; i < 4; ++i) vr[i] = *(const u32x4*)(V + (size_t)(row0 + srow) * DM + (g + 1) * 128 + ((lane >> 4) + 4 * i) * 8); }
            f32x4 acc[8];
#pragma unroll
            for (int n = 0; n < 8; ++n) acc[n] = (f32x4){0.f, 0.f, 0.f, 0.f};
#pragma unroll
            for (int ks = 0; ks < 4; ++ks) { if (ks < nks) {
#pragma unroll
                for (int n = 0; n < 8; ++n) { const bf16x8 bv = *(const LAS bf16x8*)(VT + (n * 16 + (lane & 15)) * VTP + ks * 32 + 8 * (lane >> 4));
                    acc[n] = __builtin_amdgcn_mfma_f32_16x16x32_bf16(bv, af[ks], acc[n], 0, 0, 0); } } }
#pragma unroll
            for (int n = 0; n < 8; ++n) { const int col = g * 128 + n * 16 + 4 * (lane >> 4); u32x2 yw;
                yw.x = pk_bf16(bf_lo(uw[n].x) * (acc[n][0] + bs), bf_hi(uw[n].x) * (acc[n][1] + bs)); yw.y = pk_bf16(bf_lo(uw[n].y) * (acc[n][2] + bs), bf_hi(uw[n].y) * (acc[n][3] + bs));
                *(u32x2*)(Y + rowoff + col) = yw; }
            __syncthreads();
        }
    }
}

__device__ __forceinline__ fox::BlockRef<bf16, bf16> attn_ref(int L, int pass, const bf16* Q, const bf16* K, const bf16* V, bf16* O, const float* G) {
    const int bh = L >> 3, x = L & 7, qb = pass ? 15 - x : x, b = bh >> 4, h = bh & 15;
    fox::BlockRef<bf16, bf16> r; const size_t koff = (size_t)bh * SEQ * fox::PITCH, qoff = koff + (size_t)qb * fox::QB * fox::PITCH, ooff = ((size_t)b * SEQ + (size_t)qb * fox::QB) * fox::OPITCH + h * 128;
    r.Q = Q + qoff; r.O = O + ooff; r.K = K + koff; r.V = V + koff; r.G = G + (size_t)bh * SEQ; r.P0 = qb * fox::QB;
    return r;
}
template <bool NB = false>
__device__ __forceinline__ void attn_phase(char* lds, const bf16* Q, const bf16* K, const bf16* V, bf16* O, const float* G, int vcu, int nwg) {
    constexpr int total = BATCH * NH * 8;
    int L = vcu; if (L >= total) return;
    int pass = 0;
    fox::BlockRef<bf16, bf16> cur = attn_ref(L, 0, Q, K, V, O, G);
    fox::Seam<bf16> S;
    fox::causal_swa_prime<bf16, bf16>(cur, SEQ, lds, S);
    for (;;) {
        const bool more_pass = pass == 0, more_item = L + nwg < total, last = !more_pass && !more_item;
        int passn = pass + 1, Ln = L;
        if (!more_pass) { passn = 0; Ln = more_item ? L + nwg : L; }
        const fox::BlockRef<bf16, bf16> nxt = last ? cur : attn_ref(Ln, passn, Q, K, V, O, G);
        fox::causal_swa_block<bf16, bf16, NB>(cur, nxt, SEQ, SEQ, lds, S);
        if (last) break;
        cur = nxt; pass = passn; L = Ln;
    }
}

__global__ void __launch_bounds__(NTHR, 2) fwd_kernel(Args args) {
    extern __shared__ __attribute__((aligned(16))) unsigned char lds_raw[];
    LAS unsigned char* lds = (LAS unsigned char*)lds_raw;
    const int G = gridDim.x;
#define INP(i) ((const float*)ka[i])
#define FRESH() int tid = threadIdx.x; asm volatile("" : "+v"(tid)); const int lane = tid & 63, wave = __builtin_amdgcn_readfirstlane(tid >> 6); int bx = blockIdx.x; asm volatile("" : "+s"(bx)); const int vcu = (G % 8 == 0) ? (bx % 8) * (G / 8) + bx / 8 : bx; (void)lane; (void)wave; (void)vcu; const __attribute__((address_space(4))) unsigned long long* ka = (const __attribute__((address_space(4))) unsigned long long*)__builtin_amdgcn_kernarg_segment_ptr(); asm volatile("" : "+s"(ka)); unsigned char* ws = (unsigned char*)ka[21]; const float* x = INP(0); float* mod = (float*)(ws + WS_MOD); float* logf_b = (float*)(ws + WS_LOGF); float* Gb = (float*)(ws + WS_G); bf16* Wm = (bf16*)(ws + WS_WM); bf16* WAin = (bf16*)(ws + WS_WAIN); bf16* WAout = (bf16*)(ws + WS_WAOUT); bf16* WBin = (bf16*)(ws + WS_WBIN); bf16* WBout = (bf16*)(ws + WS_WBOUT); bf16* Wgu = (bf16*)(ws + WS_WGU); bf16* Wdn = (bf16*)(ws + WS_WDN); bf16* Hb = (bf16*)(ws + WS_H); bf16* R1 = (bf16*)(ws + WS_R1); bf16* RA = (bf16*)(ws + WS_RA); bf16* XA = (bf16*)(ws + WS_X); float* XF = (float*)(ws + WS_R1);    (void)x; (void)mod; (void)logf_b; (void)Gb; (void)Wm; (void)WAin; (void)WAout; (void)WBin; (void)WBout; (void)Wgu; (void)Wdn; (void)Hb; (void)R1; (void)RA; (void)XA; (void)XF;
    unsigned char* ws0 = args.ws;
    const int lo = MK_ONE_LAUNCH ? 0 : args.ph_lo, hi = MK_ONE_LAUNCH ? NPHASE : args.ph_hi;
    if (threadIdx.x < 16) ((LAS unsigned*)(lds + MISC_OFF))[threadIdx.x] = 0u;
    __syncthreads();
    XcdBarrier bar = xcd_barrier_post((unsigned*)(ws0 + WS_CTL) + CW_BAR, (volatile LAS unsigned*)(lds + MISC_OFF));
    int ph = 0;
#define IN_PH() (lo <= ph && ph < hi)
#ifdef PROBE_BAR2
#define PROBE_BAR_EXTRA xcd_barrier(bar);
#else
#define PROBE_BAR_EXTRA
#endif
#define SEAM() do { if (IN_PH() && ph + 1 < hi) { if (ph == 0 && args.ph_lo < 0) cg::this_grid().sync(); else { xcd_barrier(bar); PROBE_BAR_EXTRA } } ++ph; } while (0)

    if (IN_PH()) { FRESH();
        P0Ptrs P; P.a_w_in = INP(6); P.a_w_out = INP(12); P.b_w_in = INP(13); P.b_w_out = INP(15); P.w_gate = INP(16); P.w_up = INP(17); P.w_down = INP(18);
        P.a_w_s = INP(10); P.c = INP(1); P.ada_w = INP(2); P.ada_b = INP(3);
        P.WAin = WAin; P.WAout = WAout; P.WBin = WBin; P.WBout = WBout; P.Wgu = Wgu; P.Wdn = Wdn; P.Wm = Wm; P.mod = mod;
        p0_prologue(lds, P, vcu, G, tid, wave, lane);
#ifdef PROBE_P02
        __syncthreads(); P.mod = (float*)(ws + WS_RA); p0_prologue(lds, P, vcu, G, tid, wave, lane); __syncthreads(); p0_prologue(lds, P, vcu, G, tid, wave, lane);
#endif
    }
    SEAM();
    { constexpr int layer = 0;
#undef modl
#define modl (mod + (size_t)layer * BATCH * MODS)
        if (IN_PH()) { FRESH();
            if (layer == 0) { norm_phase<0, false>(lds, x, INP(4), modl, modl + DM, Hb, nullptr, nullptr, nullptr, nullptr, tid, wave, lane);
#ifdef PROBE_NORM2
            __syncthreads(); norm_phase<0, false>(lds, x, INP(4), modl, modl + DM, Hb, nullptr, nullptr, nullptr, nullptr, tid, wave, lane);
#endif
            }
            else { norm_phase<2, true>(lds, XA, INP(4) + DM, modl, modl + DM, Hb, nullptr, INP(13), INP(14), logf_b, tid, wave, lane);
#if defined(PROBE_NORM2) || defined(PROBE_NORM2M)
            __syncthreads(); norm_phase<2, true>(lds, XA, INP(4) + DM, modl, modl + DM, Hb, nullptr, INP(13), INP(14), logf_b, tid, wave, lane);
#endif
            }
        }
        SEAM();
        if (IN_PH()) { FRESH();
            if (layer == 0) {
                pg8::Gemm g{Hb, WAin, M, 2 * DM, DM}; pg8::StaticOrder S; S.init(M, 2 * DM, G, bx);
                pg8::EpiBf16<1> E{R1, DM, INP(7), DM, SZ_ACT / 2, 1.f};
                pg8::gemm_phase<pg8::EpiBf16<1>, pg8::StaticOrder, PG8_ALIGN, PG8_SP2>(lds, g, S, E);
            } else {
                cumsum_phase(lds, logf_b, Gb, tid, wave, lane);
                pg8::Gemm g{Hb, WBin, M, 3 * DM, DM}; pg8::StaticOrder S; S.init(M, 3 * DM, G, bx);
                pg8::EpiQKV E{R1, SZ_ACT / 2, SEQ, NH};
                pg8::gemm_phase<pg8::EpiQKV, pg8::StaticOrder, PG8_ALIGN, PG8_SP2>(lds, g, S, E);
            }
        }
        SEAM();
        if (IN_PH()) { FRESH();
            if (layer == 0) sgu_phase(lds, R1, R1 + SZ_ACT / 2, R1 + SZ_ACT, Wm, INP(8), INP(9), INP(11), tid, wave, lane);
#ifdef PROBE_SGU2
            if (layer == 0) { xcd_barrier(bar); sgu_phase(lds, R1, R1 + SZ_ACT / 2, R1 + SZ_ACT, Wm, INP(8), INP(9), INP(11), tid, wave, lane); }
#endif
            else attn_phase((char*)lds_raw, R1, R1 + SZ_ACT / 2, R1 + SZ_ACT, RA, Gb, vcu, G);
#ifdef PROBE_ATT2
            if (layer == 1) { xcd_barrier(bar); attn_phase<true>((char*)lds_raw, R1, R1 + SZ_ACT / 2, R1 + SZ_ACT, RA + SZ_ACT / 2, Gb, vcu, G); }
#endif
        }
        SEAM();
        if (IN_PH()) { FRESH();
            pg8::Gemm g{(layer == 0) ? (const bf16*)(R1 + SZ_ACT) : (const bf16*)RA, (layer == 0) ? WAout : WBout, M, DM, DM}; pg8::StaticOrder S; S.init(M, DM, G, bx);
            if (layer == 0) { pg8::EpiRes2<float, bf16> E{x, XA, DM, modl + 2 * DM, MODS, SEQ}; pg8::gemm_phase<pg8::EpiRes2<float, bf16>, pg8::StaticOrder, PG8_ALIGN, PG8_SP2>(lds, g, S, E); }
            else { pg8::EpiRes2<bf16, bf16> E{XA, XA, DM, modl + 2 * DM, MODS, SEQ}; pg8::gemm_phase<pg8::EpiRes2<bf16, bf16>, pg8::StaticOrder, PG8_ALIGN, PG8_SP2>(lds, g, S, E); }
        }
        SEAM();
        if (IN_PH()) { FRESH(); norm_phase<0, true>(lds, XA, INP(5) + (size_t)layer * DM, modl + 3 * DM, modl + 4 * DM, Hb, nullptr, nullptr, nullptr, nullptr, tid, wave, lane);
#ifdef PROBE_NORM2
            __syncthreads(); norm_phase<0, true>(lds, XA, INP(5) + (size_t)layer * DM, modl + 3 * DM, modl + 4 * DM, Hb, nullptr, nullptr, nullptr, nullptr, tid, wave, lane);
#endif
 }
        SEAM();
        if (IN_PH()) { FRESH();
            pg8::Gemm g{Hb, Wgu + (size_t)layer * 2 * FFH * DM, M, 2 * FFH, DM}; pg8::StaticOrder S; S.init(M, 2 * FFH, G, bx);
            pg8::EpiSwiGLU E{RA, FFH};
            pg8::gemm_phase<pg8::EpiSwiGLU, pg8::StaticOrder, PG8_ALIGN, PG8_SP2>(lds, g, S, E);
#ifdef PROBE_GU2
            if (layer == 0) { xcd_barrier(bar); pg8::gemm_phase<pg8::EpiSwiGLU, pg8::StaticOrder, PG8_ALIGN, PG8_SP2>(lds, g, S, E); }
#endif
        }
        SEAM();
        if (IN_PH()) { FRESH();
            pg8::Gemm g{RA, Wdn + (size_t)layer * DM * FFH, M, DM, FFH}; pg8::StaticOrder S; S.init(M, DM, G, bx);
            if (layer == 0) { pg8::EpiRes2<bf16, bf16> E{XA, XA, DM, modl + 5 * DM, MODS, SEQ}; pg8::gemm_phase<pg8::EpiRes2<bf16, bf16>, pg8::StaticOrder, PG8_ALIGN, PG8_SP2>(lds, g, S, E); }
            else { pg8::EpiRes2<bf16, float> E{XA, XF, DM, modl + 5 * DM, MODS, SEQ}; pg8::gemm_phase<pg8::EpiRes2<bf16, float>, pg8::StaticOrder, PG8_ALIGN, PG8_SP2>(lds, g, S, E); }
        }
        SEAM();
        }
    { constexpr int layer = 1;
#undef modl
#define modl (mod + (size_t)layer * BATCH * MODS)
        if (IN_PH()) { FRESH();
            if (layer == 0) { norm_phase<0, false>(lds, x, INP(4), modl, modl + DM, Hb, nullptr, nullptr, nullptr, nullptr, tid, wave, lane);
#ifdef PROBE_NORM2
            __syncthreads(); norm_phase<0, false>(lds, x, INP(4), modl, modl + DM, Hb, nullptr, nullptr, nullptr, nullptr, tid, wave, lane);
#endif
            }
            else { norm_phase<2, true>(lds, XA, INP(4) + DM, modl, modl + DM, Hb, nullptr, INP(13), INP(14), logf_b, tid, wave, lane);
#if defined(PROBE_NORM2) || defined(PROBE_NORM2M)
            __syncthreads(); norm_phase<2, true>(lds, XA, INP(4) + DM, modl, modl + DM, Hb, nullptr, INP(13), INP(14), logf_b, tid, wave, lane);
#endif
            }
        }
        SEAM();
        if (IN_PH()) { FRESH();
            if (layer == 0) {
                pg8::Gemm g{Hb, WAin, M, 2 * DM, DM}; pg8::StaticOrder S; S.init(M, 2 * DM, G, bx);
                pg8::EpiBf16<1> E{R1, DM, INP(7), DM, SZ_ACT / 2, 1.f};
                pg8::gemm_phase<pg8::EpiBf16<1>, pg8::StaticOrder, PG8_ALIGN, PG8_SP2>(lds, g, S, E);
            } else {
                cumsum_phase(lds, logf_b, Gb, tid, wave, lane);
                pg8::Gemm g{Hb, WBin, M, 3 * DM, DM}; pg8::StaticOrder S; S.init(M, 3 * DM, G, bx);
                pg8::EpiQKV E{R1, SZ_ACT / 2, SEQ, NH};
                pg8::gemm_phase<pg8::EpiQKV, pg8::StaticOrder, PG8_ALIGN, PG8_SP2>(lds, g, S, E);
            }
        }
        SEAM();
        if (IN_PH()) { FRESH();
            if (layer == 0) sgu_phase(lds, R1, R1 + SZ_ACT / 2, R1 + SZ_ACT, Wm, INP(8), INP(9), INP(11), tid, wave, lane);
#ifdef PROBE_SGU2
            if (layer == 0) { xcd_barrier(bar); sgu_phase(lds, R1, R1 + SZ_ACT / 2, R1 + SZ_ACT, Wm, INP(8), INP(9), INP(11), tid, wave, lane); }
#endif
            else attn_phase((char*)lds_raw, R1, R1 + SZ_ACT / 2, R1 + SZ_ACT, RA, Gb, vcu, G);
#ifdef PROBE_ATT2
            if (layer == 1) { xcd_barrier(bar); attn_phase<true>((char*)lds_raw, R1, R1 + SZ_ACT / 2, R1 + SZ_ACT, RA + SZ_ACT / 2, Gb, vcu, G); }
#endif
        }
        SEAM();
        if (IN_PH()) { FRESH();
            pg8::Gemm g{(layer == 0) ? (const bf16*)(R1 + SZ_ACT) : (const bf16*)RA, (layer == 0) ? WAout : WBout, M, DM, DM}; pg8::StaticOrder S; S.init(M, DM, G, bx);
            if (layer == 0) { pg8::EpiRes2<float, bf16> E{x, XA, DM, modl + 2 * DM, MODS, SEQ}; pg8::gemm_phase<pg8::EpiRes2<float, bf16>, pg8::StaticOrder, PG8_ALIGN, PG8_SP2>(lds, g, S, E); }
            else { pg8::EpiRes2<bf16, bf16> E{XA, XA, DM, modl + 2 * DM, MODS, SEQ}; pg8::gemm_phase<pg8::EpiRes2<bf16, bf16>, pg8::StaticOrder, PG8_ALIGN, PG8_SP2>(lds, g, S, E); }
        }
        SEAM();
        if (IN_PH()) { FRESH(); norm_phase<0, true>(lds, XA, INP(5) + (size_t)layer * DM, modl + 3 * DM, modl + 4 * DM, Hb, nullptr, nullptr, nullptr, nullptr, tid, wave, lane);
#ifdef PROBE_NORM2
            __syncthreads(); norm_phase<0, true>(lds, XA, INP(5) + (size_t)layer * DM, modl + 3 * DM, modl + 4 * DM, Hb, nullptr, nullptr, nullptr, nullptr, tid, wave, lane);
#endif
 }
        SEAM();
        if (IN_PH()) { FRESH();
            pg8::Gemm g{Hb, Wgu + (size_t)layer * 2 * FFH * DM, M, 2 * FFH, DM}; pg8::StaticOrder S; S.init(M, 2 * FFH, G, bx);
            pg8::EpiSwiGLU E{RA, FFH};
            pg8::gemm_phase<pg8::EpiSwiGLU, pg8::StaticOrder, PG8_ALIGN, PG8_SP2>(lds, g, S, E);
#ifdef PROBE_GU2
            if (layer == 0) { xcd_barrier(bar); pg8::gemm_phase<pg8::EpiSwiGLU, pg8::StaticOrder, PG8_ALIGN, PG8_SP2>(lds, g, S, E); }
#endif
        }
        SEAM();
        if (IN_PH()) { FRESH();
            pg8::Gemm g{RA, Wdn + (size_t)layer * DM * FFH, M, DM, FFH}; pg8::StaticOrder S; S.init(M, DM, G, bx);
            if (layer == 0) { pg8::EpiRes2<bf16, bf16> E{XA, XA, DM, modl + 5 * DM, MODS, SEQ}; pg8::gemm_phase<pg8::EpiRes2<bf16, bf16>, pg8::StaticOrder, PG8_ALIGN, PG8_SP2>(lds, g, S, E); }
            else { pg8::EpiRes2<bf16, float> E{XA, XF, DM, modl + 5 * DM, MODS, SEQ}; pg8::gemm_phase<pg8::EpiRes2<bf16, float>, pg8::StaticOrder, PG8_ALIGN, PG8_SP2>(lds, g, S, E); }
        }
        SEAM();
        }
    if (IN_PH()) { FRESH(); norm_phase<1, false>(lds, XF, INP(19), nullptr, nullptr, nullptr, (float*)ka[20], nullptr, nullptr, nullptr, tid, wave, lane);
#ifdef PROBE_NORM2
            __syncthreads(); norm_phase<1, false>(lds, XF, INP(19), nullptr, nullptr, nullptr, (float*)ka[20], nullptr, nullptr, nullptr, tid, wave, lane);
#endif
 }
#undef IN_PH
#undef SEAM
}

extern "C" void kernel_launch(void* const* d_in, const int* in_sizes, int n_in, void* d_out, int out_size, void* d_ws, size_t ws_size, hipStream_t stream) {
    static int grid = 0;
    if (grid == 0) {
        if (n_in != 20 || in_sizes[0] != M * DM || out_size != M * DM || ws_size < WS_END) { fprintf(stderr, "kernel_launch: unexpected shapes (n_in %d, in0 %d, out %d, ws %zu)\n", n_in, n_in > 0 ? in_sizes[0] : -1, out_size, ws_size); grid = -1; return; }
        int dev = 0, cus = 0, per_cu = 0;
        (void)hipGetDevice(&dev); (void)hipDeviceGetAttribute(&cus, hipDeviceAttributeMultiprocessorCount, dev);
        if (hipFuncSetAttribute((const void*)fwd_kernel, hipFuncAttributeMaxDynamicSharedMemorySize, LDS_BYTES) != hipSuccess) { fprintf(stderr, "kernel_launch: hipFuncSetAttribute failed\n"); grid = -1; return; }
        if (hipOccupancyMaxActiveBlocksPerMultiprocessor(&per_cu, (const void*)fwd_kernel, NTHR, LDS_BYTES) != hipSuccess || per_cu < 1) { fprintf(stderr, "kernel_launch: occupancy query says %d\n", per_cu); per_cu = 1; }
        (void)hipGetLastError();
        grid = cus > 0 ? cus : 256;
        fprintf(stderr, "kernel_launch: grid %d (cus %d, per_cu %d)\n", grid, cus, per_cu);
    }
    if (grid < 0) return;
    (void)hipMemsetAsync((char*)d_ws + WS_CTL, 0, ZERO_BYTES, stream);
    Args a{};
    for (int i = 0; i < 20; ++i) a.in[i] = (const float*)d_in[i];
    a.out = (float*)d_out; a.ws = (unsigned char*)d_ws;
#if MK_ONE_LAUNCH
    a.ph_lo = 0; a.ph_hi = NPHASE;
    void* kargs[] = {&a};
    hipError_t e = hipLaunchCooperativeKernel((const void*)fwd_kernel, dim3(grid), dim3(NTHR), kargs, LDS_BYTES, stream);
    if (e != hipSuccess) fprintf(stderr, "kernel_launch: cooperative launch failed: %s (grid %d)\n", hipGetErrorString(e), grid);
#else
    for (int p = 0; p < NPHASE; ++p) { a.ph_lo = p; a.ph_hi = p + 1; hipLaunchKernelGGL(fwd_kernel, dim3(grid), dim3(NTHR), LDS_BYTES, stream, a); }
#endif
}
```

```cpp
#include <hip/hip_runtime.h>
#include <hip/hip_cooperative_groups.h>
#include <cstdio>
#include <cstdint>
namespace cg = cooperative_groups;
#ifndef PG8_WGM
#define PG8_WGM 2
#endif
namespace pg8 {
#define PG8_LAS __attribute__((address_space(3)))
typedef unsigned short bf16_t;
typedef short bf16x8 __attribute__((ext_vector_type(8)));
typedef float f32x4 __attribute__((ext_vector_type(4)));
typedef unsigned u32x4 __attribute__((ext_vector_type(4)));
constexpr int BM = 256, BK = 64, HALF = 128, HTB = HALF * BK * 2  , STAGE_BYTES = 8 * HTB, NXCD = 8, WGM = PG8_WGM;

__host__ __device__ __forceinline__ int lds_byte(int r, int c) { const int st = (r >> 4) * 2 + (c >> 5), rr = r & 15, cc = c & 31, ob = rr * 64 + cc * 2; return st * 1024 + (ob ^ (((ob >> 9) & 1) << 5)); }
__host__ __device__ __forceinline__ void stage_rc(int b, int& R, int& C) { const int st = b / 1024, sb = b % 1024, swz = sb ^ (((sb >> 9) & 1) << 5); R = (st >> 1) * 16 + swz / 64; C = (st & 1) * 32 + (swz % 64) / 2; }
__host__ __device__ __forceinline__ int perm32(int rho) { const int n = rho >> 4, i = rho & 15; return 8 * (i >> 2) + 4 * n + (i & 3); }

struct Unit { int pm, pn; };
struct Gemm { const bf16_t* A; const bf16_t* Bt; int M, N, K; };

struct StaticOrder {
    int nM, nN, nwg, G, c;
    __host__ __device__ void init(int M, int N, int G_, int c_) { nM = M / BM; nN = N / BM; nwg = nM * nN; G = G_; c = c_; }
    __host__ __device__ bool next(int i, Unit& u) const {
        const long L = (long)i * G + c; if (L >= nwg) return false;
        int wgid = (int)L; { const int q = nwg / NXCD, r = nwg % NXCD, xcd = wgid % NXCD, off = wgid / NXCD; wgid = (xcd < r ? xcd * (q + 1) : r * (q + 1) + (xcd - r) * q) + off; }
        const int nig = WGM * nN, gid = wgid / nig, fm = gid * WGM, gsz = (nM - fm) < WGM ? (nM - fm) : WGM;
        u.pm = fm + ((wgid % nig) % gsz); u.pn = (wgid % nig) / gsz;
        if (gid & 1) u.pn = nN - 1 - u.pn;
        return true;
    }
    __device__ __forceinline__ void a_ready(const Unit&) const {}
    __device__ __forceinline__ void done(const Unit&) const {}
};

__device__ __forceinline__ unsigned cvt_pk_bf16(float lo, float hi) { unsigned r; asm volatile("v_cvt_pk_bf16_f32 %0, %1, %2" : "=v"(r) : "v"(lo), "v"(hi)); return r; }
typedef float f32x2 __attribute__((ext_vector_type(2)));
__device__ __forceinline__ f32x2 gelu_pk(f32x2 v) {
    const f32x2 av = __builtin_elementwise_abs(v), d = av * 0.2316418882f + 1.0f;
    f32x2 t; t.x = __builtin_amdgcn_rcpf(d.x); t.y = __builtin_amdgcn_rcpf(d.y);
    f32x2 q = t * 0.5307027145f + (-0.7265760135f); q = q * t + 0.7107068705f; q = q * t + (-0.142248368f); q = q * t + 0.127414796f; q = q * t;
    const f32x2 s = (v * v) * (-0.72134752044f);
    f32x2 e; e.x = __builtin_amdgcn_exp2f(s.x); e.y = __builtin_amdgcn_exp2f(s.y);
    const f32x2 m = v * (q * e), r = v - m;
    f32x2 o; o.x = v.x < 0.f ? m.x : r.x; o.y = v.y < 0.f ? m.y : r.y; return o;
}

template <int ACT  > struct EpiBf16 {
    static constexpr bool PERM = true, AFTER_DRAIN = false; static_assert(ACT == 0 || ACT == 1, "EpiBf16: ACT is 0 (none) or 1 (gelu_pk)");
    bf16_t* O; int ldc; const float* bias; int split_cols; size_t split_stride; float scale0;
    __device__ __forceinline__ void operator()(const f32x4 (&acc)[2][2][4][2], const Unit& u, int wr, int wc, int fr, int fq) const {
        const int row0 = u.pm * BM + wr * 64 + fr; int colt = u.pn * BM; bf16_t* base = O;
        float sc = 1.f; if (split_cols) { const int t = colt / split_cols; base += (size_t)t * split_stride; colt -= t * split_cols; if (t == 0) sc = scale0; }
        const int col0 = colt + wc * 32 + 8 * fq, bcol0 = u.pn * BM + wc * 32 + 8 * fq;
        f32x4 bv[2][2];
#pragma unroll
        for (int bj = 0; bj < 2; ++bj)
#pragma unroll
            for (int n = 0; n < 2; ++n) bv[bj][n] = bias ? *(const f32x4*)(bias + bcol0 + bj * HALF + 4 * n) : (f32x4){0.f, 0.f, 0.f, 0.f};
#pragma unroll
        for (int ai = 0; ai < 2; ++ai)
#pragma unroll
            for (int m = 0; m < 4; ++m) { bf16_t* rowp = base + (size_t)(row0 + ai * HALF + m * 16) * ldc + col0;
#pragma unroll
                for (int bj = 0; bj < 2; ++bj) { f32x4 v0 = acc[ai][bj][m][0] + bv[bj][0], v1 = acc[ai][bj][m][1] + bv[bj][1];
                    if (ACT == 1) { f32x2 a = gelu_pk((f32x2){v0[0], v0[1]}), b = gelu_pk((f32x2){v0[2], v0[3]}), c = gelu_pk((f32x2){v1[0], v1[1]}), d = gelu_pk((f32x2){v1[2], v1[3]});
                        v0 = (f32x4){a.x, a.y, b.x, b.y}; v1 = (f32x4){c.x, c.y, d.x, d.y}; }
                    v0 = v0 * sc; v1 = v1 * sc; u32x4 w; w.x = cvt_pk_bf16(v0[0], v0[1]); w.y = cvt_pk_bf16(v0[2], v0[3]); w.z = cvt_pk_bf16(v1[0], v1[1]); w.w = cvt_pk_bf16(v1[2], v1[3]);
                    *(u32x4*)(rowp + bj * HALF) = w; } }
    }
};
template <class Epi, class Sched, bool ALIGN_EPI = false, bool SP2 = false>
__device__ __forceinline__ void gemm_phase(PG8_LAS unsigned char* lds, const Gemm g, const Sched& S, const Epi& E) {
    int tid_ = threadIdx.x; asm volatile("" : "+v"(tid_)); const int tid = tid_, wid = __builtin_amdgcn_readfirstlane(tid >> 6), lane = tid & 63, wr = wid >> 2, wc = wid & 3, fr = lane & 15, fq = lane >> 4;
    const int K = g.K, nt = K / BK;
    unsigned voffA[2], voffB[2];
#pragma unroll
    for (int i = 0; i < 2; ++i) { int R, C; stage_rc(tid * 16 + i * 8192, R, C); const int Rb = Epi::PERM ? ((R & ~31) + perm32(R & 31)) : R;
        voffA[i] = (unsigned)(R * K + C) * 2u; voffB[i] = (unsigned)(Rb * K + C) * 2u; }
    const size_t kstep = (size_t)(BK * 2);
    const size_t hstep = (size_t)HALF * K * 2;
    const size_t tstep = 2 * hstep;
    const unsigned ldsw = (unsigned)wid * 1024u;
    const int aoff = lds_byte(wr * 64 + fr, fq * 8), boff = lds_byte(wc * 32 + fr, fq * 8);
#define PG8_SA(b, h) (((b) * 2 + (h)) * HTB)
#define PG8_SB(b, h) ((4 + (b) * 2 + (h)) * HTB)
#define PG8_STAGE(bufoff, gbase, voff) do { _Pragma("unroll") for (int _i = 0; _i < 2; ++_i) \
        __builtin_amdgcn_global_load_lds((const unsigned*)((const char*)(gbase) + (voff)[_i]), (PG8_LAS unsigned*)(lds + (bufoff) + ldsw + _i * 8192), 16, 0, 0); } while (0)
#define PG8_LDA(dst, b, h) do { _Pragma("unroll") for (int m = 0; m < 4; ++m) _Pragma("unroll") for (int k = 0; k < 2; ++k) dst[m][k] = *(const PG8_LAS bf16x8*)(lds + PG8_SA(b, h) + aoff + m * 2048 + k * 1024); } while (0)
#define PG8_LDB(dst, b, h) do { _Pragma("unroll") for (int n = 0; n < 2; ++n) _Pragma("unroll") for (int k = 0; k < 2; ++k) dst[n][k] = *(const PG8_LAS bf16x8*)(lds + PG8_SB(b, h) + boff + n * 2048 + k * 1024); } while (0)
#define PG8_MMA(ai, bj, At, Bt) do { __builtin_amdgcn_s_setprio(1); _Pragma("unroll") for (int m = 0; m < 4; ++m) _Pragma("unroll") for (int n = 0; n < 2; ++n) _Pragma("unroll") for (int k = 0; k < 2; ++k) \
        acc[ai][bj][m][n] = __builtin_amdgcn_mfma_f32_16x16x32_bf16(Bt[n][k], At[m][k], acc[ai][bj][m][n], 0, 0, 0); __builtin_amdgcn_s_setprio(0); } while (0)
#define PG8_WAIT_V(n) asm volatile("s_waitcnt vmcnt(" #n ")" ::: "memory")
#define PG8_WAIT_L(n) asm volatile("s_waitcnt lgkmcnt(" #n ")" ::: "memory")
#define PG8_BAR __builtin_amdgcn_s_barrier()
#define PG8_SCHED __builtin_amdgcn_sched_barrier(0)
    Unit cur, nxt; int ui = 0;
    if (!S.next(0, cur)) return;
    f32x4 acc[2][2][4][2];
#pragma unroll
    for (int a = 0; a < 2; ++a)
#pragma unroll
        for (int b = 0; b < 2; ++b)
#pragma unroll
            for (int m = 0; m < 4; ++m)
#pragma unroll
                for (int n = 0; n < 2; ++n) acc[a][b][m][n] = (f32x4){0.f, 0.f, 0.f, 0.f};
    bf16x8 At[4][2], B0[2][2], B1[2][2];
    const char* cA = (const char*)g.A + (size_t)cur.pm * tstep; const char* cB = (const char*)g.Bt + (size_t)cur.pn * tstep;
    S.a_ready(cur);
    if constexpr (SP2) {
        PG8_STAGE(PG8_SB(0, 0), cB, voffB); PG8_STAGE(PG8_SB(0, 1), cB + hstep, voffB); PG8_STAGE(PG8_SA(0, 0), cA, voffA); PG8_STAGE(PG8_SA(0, 1), cA + hstep, voffA);
        if (wr == 1) PG8_BAR;
        PG8_WAIT_V(2); PG8_BAR;
        PG8_STAGE(PG8_SB(1, 0), cB + kstep, voffB); PG8_STAGE(PG8_SA(1, 0), cA + kstep, voffA); PG8_STAGE(PG8_SB(1, 1), cB + hstep + kstep, voffB);
        PG8_WAIT_V(6); PG8_BAR;
    } else {
        PG8_STAGE(PG8_SB(0, 0), cB, voffB); PG8_STAGE(PG8_SA(0, 0), cA, voffA); PG8_STAGE(PG8_SB(0, 1), cB + hstep, voffB); PG8_STAGE(PG8_SA(0, 1), cA + hstep, voffA);
        if (wr == 1) PG8_BAR;
        PG8_WAIT_V(4); PG8_BAR;
        PG8_STAGE(PG8_SB(1, 0), cB + kstep, voffB); PG8_STAGE(PG8_SA(1, 0), cA + kstep, voffA); PG8_STAGE(PG8_SB(1, 1), cB + hstep + kstep, voffB);
        PG8_WAIT_V(6); PG8_BAR;
    }
    for (;;) {
        const bool has_next = S.next(ui + 1, nxt);
        const char* nA = has_next ? (const char*)g.A + (size_t)nxt.pm * tstep : cA; const char* nB = has_next ? (const char*)g.Bt + (size_t)nxt.pn * tstep : cB;
        for (int t = 0; t < nt; t += 2) {
            const bool last = (t == nt - 2);
            const char* a1 = cA + (size_t)(t + 1) * kstep;
            const char* a2 = last ? nA : cA + (size_t)(t + 2) * kstep; const char* b2 = last ? nB : cB + (size_t)(t + 2) * kstep;
            const char* a3 = a2 + kstep; const char* b3 = b2 + kstep;
            if (last && has_next) S.a_ready(nxt);
            if constexpr (SP2) {
            PG8_LDB(B0, 0, 0); PG8_LDB(B1, 0, 1); PG8_SCHED; PG8_LDA(At, 0, 0); PG8_STAGE(PG8_SA(1, 1), a1 + hstep, voffA);
            PG8_WAIT_V(8); PG8_WAIT_L(0); PG8_BAR; PG8_MMA(0, 0, At, B0); PG8_MMA(0, 1, At, B1); PG8_BAR; PG8_SCHED;
            PG8_LDA(At, 0, 1); PG8_STAGE(PG8_SB(0, 0), b2, voffB); PG8_STAGE(PG8_SB(0, 1), b2 + hstep, voffB); PG8_STAGE(PG8_SA(0, 0), a2, voffA);
            PG8_WAIT_V(8); PG8_WAIT_L(0); PG8_BAR; PG8_MMA(1, 0, At, B0); PG8_MMA(1, 1, At, B1); PG8_BAR; PG8_SCHED;
            PG8_LDB(B0, 1, 0); PG8_LDB(B1, 1, 1); PG8_SCHED; PG8_LDA(At, 1, 0); PG8_STAGE(PG8_SA(0, 1), a2 + hstep, voffA);
            PG8_WAIT_V(8); PG8_WAIT_L(0); PG8_BAR; PG8_MMA(0, 0, At, B0); PG8_MMA(0, 1, At, B1); PG8_BAR; PG8_SCHED;
            PG8_LDA(At, 1, 1); PG8_STAGE(PG8_SB(1, 0), b3, voffB); PG8_STAGE(PG8_SB(1, 1), b3 + hstep, voffB); PG8_STAGE(PG8_SA(1, 0), a3, voffA);
            PG8_WAIT_V(8); PG8_WAIT_L(0); PG8_BAR; PG8_MMA(1, 0, At, B0); PG8_MMA(1, 1, At, B1); PG8_BAR; PG8_SCHED;
            } else {
            PG8_LDB(B0, 0, 0); PG8_SCHED; PG8_LDA(At, 0, 0); PG8_STAGE(PG8_SA(1, 1), a1 + hstep, voffA);
            PG8_WAIT_L(8); PG8_BAR; PG8_WAIT_L(0); PG8_MMA(0, 0, At, B0); PG8_BAR; PG8_SCHED;
            PG8_LDB(B1, 0, 1); PG8_STAGE(PG8_SB(0, 0), b2, voffB);
            PG8_BAR; PG8_WAIT_L(0); PG8_MMA(0, 1, At, B1); PG8_BAR;
            PG8_LDA(At, 0, 1); PG8_STAGE(PG8_SA(0, 0), a2, voffA);
            PG8_BAR; PG8_WAIT_L(0); PG8_MMA(1, 0, At, B0); PG8_BAR; PG8_SCHED;
            PG8_STAGE(PG8_SB(0, 1), b2 + hstep, voffB);
            PG8_WAIT_V(6); PG8_BAR; PG8_MMA(1, 1, At, B1); PG8_BAR;
            PG8_LDB(B0, 1, 0); PG8_SCHED; PG8_LDA(At, 1, 0); PG8_STAGE(PG8_SA(0, 1), a2 + hstep, voffA);
            PG8_WAIT_L(8); PG8_BAR; PG8_WAIT_L(0); PG8_MMA(0, 0, At, B0); PG8_BAR; PG8_SCHED;
            PG8_LDB(B1, 1, 1); PG8_STAGE(PG8_SB(1, 0), b3, voffB);
            PG8_BAR; PG8_WAIT_L(0); PG8_MMA(0, 1, At, B1); PG8_BAR;
            PG8_LDA(At, 1, 1); PG8_STAGE(PG8_SA(1, 0), a3, voffA);
            PG8_BAR; PG8_WAIT_L(0); PG8_MMA(1, 0, At, B0); PG8_BAR; PG8_SCHED;
            PG8_STAGE(PG8_SB(1, 1), b3 + hstep, voffB);
            PG8_WAIT_V(6); PG8_BAR; PG8_MMA(1, 1, At, B1); PG8_BAR;
            }
        }
        if constexpr (ALIGN_EPI) { if (wr == 0) PG8_BAR; }
        if constexpr (!Epi::AFTER_DRAIN) { E(acc, cur, wr, wc, fr, fq); S.done(cur); }
        if (!has_next) break;
#pragma unroll
        for (int a = 0; a < 2; ++a)
#pragma unroll
            for (int b = 0; b < 2; ++b)
#pragma unroll
                for (int m = 0; m < 4; ++m)
#pragma unroll
                    for (int n = 0; n < 2; ++n) acc[a][b][m][n] = (f32x4){0.f, 0.f, 0.f, 0.f};
        cur = nxt; cA = nA; cB = nB; ++ui;
        if constexpr (ALIGN_EPI) { if (wr == 1) PG8_BAR; }
    }
    PG8_WAIT_V(0);
    if constexpr (!ALIGN_EPI) { if (wr == 0) PG8_BAR; }
    PG8_BAR;
    if constexpr (Epi::AFTER_DRAIN) { E.fused(acc, cur, wr, wc, fr, fq, lds, wid, lane); S.done(cur); }
#undef PG8_SA
#undef PG8_SB
#undef PG8_STAGE
#undef PG8_LDA
#undef PG8_LDB
#undef PG8_MMA
#undef PG8_WAIT_V
#undef PG8_WAIT_L
#undef PG8_BAR
#undef PG8_SCHED
}
}
namespace pg8 {
struct EpiRes {
    static constexpr bool PERM = false, AFTER_DRAIN = false;
    const float* res; float* out; int ldc; const float* gate; int gate_stride; int rows_per_batch;
    __device__ __forceinline__ void operator()(const f32x4 (&acc)[2][2][4][2], const Unit& u, int wr, int wc, int fr, int fq) const {
        const int row0 = u.pm * BM + wr * 64 + fr, col0 = u.pn * BM + wc * 32 + 4 * fq;
        const float* gp = gate + (size_t)((u.pm * BM) / rows_per_batch) * gate_stride + col0;
        f32x4 gv[2][2];
#pragma unroll
        for (int bj = 0; bj < 2; ++bj)
#pragma unroll
            for (int n = 0; n < 2; ++n) gv[bj][n] = *(const f32x4*)(gp + bj * HALF + n * 16);
#pragma unroll
        for (int ai = 0; ai < 2; ++ai)
#pragma unroll
            for (int m = 0; m < 4; ++m) { const size_t off = (size_t)(row0 + ai * HALF + m * 16) * ldc + col0;
#pragma unroll
                for (int bj = 0; bj < 2; ++bj)
#pragma unroll
                    for (int n = 0; n < 2; ++n) { const f32x4 r = *(const f32x4*)(res + off + bj * HALF + n * 16); *(f32x4*)(out + off + bj * HALF + n * 16) = r + gv[bj][n] * acc[ai][bj][m][n]; }
                asm volatile("" ::: "memory"); }
    }
};
template <class TI, class TO> struct EpiRes2 {
    static constexpr bool PERM = true, AFTER_DRAIN = false;
    const TI* res; TO* out; int ldc; const float* gate; int gate_stride; int rows_per_batch;
    __device__ __forceinline__ void operator()(const f32x4 (&acc)[2][2][4][2], const Unit& u, int wr, int wc, int fr, int fq) const {
        const int row0 = u.pm * BM + wr * 64 + fr, col0 = u.pn * BM + wc * 32 + 8 * fq;
        const float* gp = gate + (size_t)((u.pm * BM) / rows_per_batch) * gate_stride + col0;
        f32x4 gv[2][2];
#pragma unroll
        for (int bj = 0; bj < 2; ++bj)
#pragma unroll
            for (int n = 0; n < 2; ++n) gv[bj][n] = *(const f32x4*)(gp + bj * HALF + 4 * n);
#pragma unroll
        for (int ai = 0; ai < 2; ++ai)
#pragma unroll
            for (int m = 0; m < 4; ++m) { const size_t off = (size_t)(row0 + ai * HALF + m * 16) * ldc + col0;
#pragma unroll
                for (int bj = 0; bj < 2; ++bj) { f32x4 r0, r1;
                    if constexpr (sizeof(TI) == 4) { r0 = *(const f32x4*)((const float*)res + off + bj * HALF); r1 = *(const f32x4*)((const float*)res + off + bj * HALF + 4); }
                    else { const u32x4 w = *(const u32x4*)((const bf16_t*)res + off + bj * HALF);
                        r0 = (f32x4){__uint_as_float(w.x << 16), __uint_as_float(w.x & 0xffff0000u), __uint_as_float(w.y << 16), __uint_as_float(w.y & 0xffff0000u)};
                        r1 = (f32x4){__uint_as_float(w.z << 16), __uint_as_float(w.z & 0xffff0000u), __uint_as_float(w.w << 16), __uint_as_float(w.w & 0xffff0000u)}; }
                    const f32x4 o0 = r0 + gv[bj][0] * acc[ai][bj][m][0], o1 = r1 + gv[bj][1] * acc[ai][bj][m][1];
                    if constexpr (sizeof(TO) == 4) { *(f32x4*)((float*)out + off + bj * HALF) = o0; *(f32x4*)((float*)out + off + bj * HALF + 4) = o1; }
                    else { u32x4 w; w.x = cvt_pk_bf16(o0[0], o0[1]); w.y = cvt_pk_bf16(o0[2], o0[3]); w.z = cvt_pk_bf16(o1[0], o1[1]); w.w = cvt_pk_bf16(o1[2], o1[3]); *(u32x4*)((bf16_t*)out + off + bj * HALF) = w; } }
                asm volatile("" ::: "memory"); }
    }
};
struct EpiSwiGLU {
    static constexpr bool PERM = true, AFTER_DRAIN = false;
    bf16_t* O; int ldc;
    __device__ __forceinline__ static float act(float g, float u) { return g * __builtin_amdgcn_rcpf(1.0f + __builtin_amdgcn_exp2f(g * -1.4426950408889634f)) * u; }
    __device__ __forceinline__ void operator()(const f32x4 (&acc)[2][2][4][2], const Unit& u, int wr, int wc, int fr, int fq) const {
        const int row0 = u.pm * BM + wr * 64 + fr, col0 = u.pn * HALF + wc * 32 + 8 * fq;
#pragma unroll
        for (int ai = 0; ai < 2; ++ai)
#pragma unroll
            for (int m = 0; m < 4; ++m) { bf16_t* rowp = O + (size_t)(row0 + ai * HALF + m * 16) * ldc + col0;
                const f32x4 g0 = acc[ai][0][m][0], g1 = acc[ai][0][m][1], u0 = acc[ai][1][m][0], u1 = acc[ai][1][m][1];
                u32x4 w; w.x = cvt_pk_bf16(act(g0[0], u0[0]), act(g0[1], u0[1])); w.y = cvt_pk_bf16(act(g0[2], u0[2]), act(g0[3], u0[3]));
                w.z = cvt_pk_bf16(act(g1[0], u1[0]), act(g1[1], u1[1])); w.w = cvt_pk_bf16(act(g1[2], u1[2]), act(g1[3], u1[3]));
                *(u32x4*)rowp = w; }
    }
};
struct EpiQKV {
    static constexpr bool PERM = true, AFTER_DRAIN = false;
    bf16_t* O; size_t tensor_stride; int seq, nheads;
    __device__ __forceinline__ void operator()(const f32x4 (&acc)[2][2][4][2], const Unit& u, int wr, int wc, int fr, int fq) const {
        const int row0 = u.pm * BM + wr * 64 + fr; const int colt = u.pn * BM; const int t = colt / (nheads * 128), head0 = (colt - t * nheads * 128) >> 7;
        const int b = (u.pm * BM) / seq, s0 = row0 - b * seq;
        bf16_t* base = O + (size_t)t * tensor_stride + ((size_t)(b * nheads + head0) * seq + s0) * 128 + wc * 32 + 8 * fq;
#pragma unroll
        for (int ai = 0; ai < 2; ++ai)
#pragma unroll
            for (int m = 0; m < 4; ++m) {
#pragma unroll
                for (int bj = 0; bj < 2; ++bj) { const f32x4 v0 = acc[ai][bj][m][0], v1 = acc[ai][bj][m][1];
                    u32x4 w; w.x = cvt_pk_bf16(v0[0], v0[1]); w.y = cvt_pk_bf16(v0[2], v0[3]); w.z = cvt_pk_bf16(v1[0], v1[1]); w.w = cvt_pk_bf16(v1[2], v1[3]);
                    *(u32x4*)(base + ((size_t)bj * seq + ai * HALF + m * 16) * 128) = w; } }
    }
};
}
#ifndef PG8_SP2
#define PG8_SP2 true
#endif
#ifndef PG8_ALIGN
#define PG8_ALIGN true
#endif
namespace fox {
constexpr int D = 128, PITCH = 128, OPITCH = 2048;
constexpr float SCALE = 0.08838834764831845f;
constexpr float THR = 8.f;
constexpr bool WSKIP = false;
constexpr int NW = 8, QBLK = 32, KVBLK = 64, QB = NW * QBLK;
constexpr int SHM_V = KVBLK * D * 2, SHM_K = KVBLK * D * 2;
constexpr int LDS_BYTES = 2 * SHM_V + 2 * SHM_K + NW * 64 * 4 + 2 * 64 * 4;
using bf16 = unsigned short;
typedef short bf16x8 __attribute__((ext_vector_type(8)));
typedef short s16x4 __attribute__((ext_vector_type(4)));
typedef float f32x16 __attribute__((ext_vector_type(16)));
typedef float f32x4 __attribute__((ext_vector_type(4)));
typedef unsigned u32x4 __attribute__((ext_vector_type(4)));
template <class A, class Bt> struct same_t { static constexpr bool v = false; };
template <class A> struct same_t<A, A> { static constexpr bool v = true; };

#define KSWZ(row, colB) ((row) * 256 + ((colB) ^ (((row) & 7) << 4)))
#define SBAR() __builtin_amdgcn_sched_barrier(0)
__device__ __forceinline__ int v_st(int k, int c) { const int kk = (k & ~0xC) | ((k & 4) << 1) | ((k & 8) >> 1); return ((kk >> 3) * 4 + (c >> 5)) * 512 + ((kk & 7) * 32 + (c & 31)) * 2; }
__device__ __forceinline__ int v_rd_base(int lane) { return ((lane & 3) << 3) | (((lane >> 2) & 3) << 6) | (((lane >> 4) & 1) << 5) | (((lane >> 5) & 1) << 8); }
constexpr int v_rd_off(int d0, int ks, int half) { return d0 * 512 + ks * 4096 + half * 2048; }
__device__ __forceinline__ int crow(int r, int hi) { return (r & 3) + 8 * (r >> 2) + 4 * hi; }
__device__ __forceinline__ unsigned cvtpk(float lo, float hi) {
    unsigned r; asm volatile("v_cvt_pk_bf16_f32 %0, %1, %2" : "=v"(r) : "v"(lo), "v"(hi)); return r;
}
__device__ __forceinline__ bf16x8 pack8(f32x4 a, f32x4 b) {
    u32x4 w = {cvtpk(a[0], a[1]), cvtpk(a[2], a[3]), cvtpk(b[0], b[1]), cvtpk(b[2], b[3])};
    return *reinterpret_cast<bf16x8*>(&w);
}
template <class T> __device__ __forceinline__ bf16x8 load8(const T* p) {
    if constexpr (same_t<T, float>::v) { return pack8(*(const f32x4*)p, *(const f32x4*)(p + 4)); }
    else { return *reinterpret_cast<const bf16x8*>(p); }
}
__device__ __forceinline__ void mask_tile(f32x16& p0, f32x16& p1, int dq, unsigned W) {
    const float NEG = -__builtin_inff();
#pragma unroll
    for (int r = 0; r < 16; ++r) {
        const int c = (r & 3) + 8 * (r >> 2);
        if ((unsigned)(dq - c) >= W) p0[r] = NEG;
        if ((unsigned)(dq - c - 32) >= W) p1[r] = NEG;
    }
}
__device__ __forceinline__ void partialSM(f32x16& p0, f32x16& p1, float& m_reg, float& mn, float& alpha) {
    float pmax = p0[0]; for (int r = 1; r < 16; ++r) pmax = fmaxf(pmax, p0[r]); for (int r = 0; r < 16; ++r) pmax = fmaxf(pmax, p1[r]);
    { auto rr = __builtin_amdgcn_permlane32_swap(__float_as_uint(pmax), __float_as_uint(pmax), false, false);
      pmax = fmaxf(__uint_as_float(rr[0]), __uint_as_float(rr[1])); }
    constexpr float C2 = 1.4426950408889634f * SCALE;
    if (__builtin_expect(__all((pmax - m_reg) * SCALE <= THR), 1)) { mn = m_reg; alpha = 1.f; }
    else { mn = fmaxf(m_reg, pmax); alpha = __builtin_amdgcn_exp2f((m_reg - mn) * C2); m_reg = mn; }
    const float mnL = -mn * C2;
    for (int r = 0; r < 16; ++r) p0[r] = fmaf(p0[r], C2, mnL); for (int r = 0; r < 16; ++r) p1[r] = fmaf(p1[r], C2, mnL);
    for (int r = 0; r < 16; ++r) p0[r] = __builtin_amdgcn_exp2f(p0[r]);
}
__device__ __forceinline__ void finishSM(f32x16& p0, f32x16& p1, float alpha, float& l_reg, bf16x8& pa0, bf16x8& pa1, bf16x8& pa2, bf16x8& pa3) {
    for (int r = 0; r < 16; ++r) p1[r] = __builtin_amdgcn_exp2f(p1[r]);
    float ps = 0; for (int r = 0; r < 16; ++r) ps += p0[r]; for (int r = 0; r < 16; ++r) ps += p1[r];
    { auto rr = __builtin_amdgcn_permlane32_swap(__float_as_uint(ps), __float_as_uint(ps), false, false);
      ps = __uint_as_float(rr[0]) + __uint_as_float(rr[1]); }
    l_reg = l_reg * alpha + ps;
#define PK4(P, B_, OUT) do { unsigned a0 = cvtpk(P[B_+0], P[B_+1]), a1 = cvtpk(P[B_+2], P[B_+3]);                          \
        unsigned b0 = cvtpk(P[B_+4], P[B_+5]), b1 = cvtpk(P[B_+6], P[B_+7]);                                             \
        auto r0 = __builtin_amdgcn_permlane32_swap(a0, b0, false, false); auto r1 = __builtin_amdgcn_permlane32_swap(a1, b1, false, false); \
        u32x4 w = {r0[0], r1[0], r0[1], r1[1]}; OUT = *reinterpret_cast<bf16x8*>(&w); } while (0)
    PK4(p0, 0, pa0); PK4(p0, 8, pa1); PK4(p1, 0, pa2); PK4(p1, 8, pa3);
#undef PK4
}
template <int KB, bool SK, bool NB = false>
__device__ __forceinline__ void qkt(f32x16& p0, f32x16& p1, const char* K_lds, int r32, int hi, const bf16x8* qr, bool act, const float* g_lds, float gt) {
    if (SK && !act) { const float NEG = -__builtin_inff();
#pragma unroll
        for (int r = 0; r < 16; ++r) { p0[r] = NEG; p1[r] = NEG; } return; }
    if constexpr (NB) { p0 = f32x16{}; p1 = f32x16{}; } else
    { const float* gl = g_lds + KB * 64 + 4 * hi;
#pragma unroll
      for (int g4 = 0; g4 < 4; ++g4) { const f32x4 a = *(const f32x4*)(gl + 8 * g4), b = *(const f32x4*)(gl + 32 + 8 * g4);
#pragma unroll
        for (int e = 0; e < 4; ++e) { p0[4 * g4 + e] = a[e]; p1[4 * g4 + e] = b[e]; } } }
    const char* kb[4];
#pragma unroll
    for (int dd = 0; dd < 4; ++dd) kb[dd] = K_lds + KB * SHM_K + KSWZ(r32, (dd * 16 + hi * 8) * 2);
#pragma unroll
    for (int d0 = 0; d0 < 8; ++d0) { const char* a = kb[d0 & 3] + (d0 >> 2) * 128;
        bf16x8 b0 = *reinterpret_cast<const bf16x8*>(a);
        bf16x8 b1 = *reinterpret_cast<const bf16x8*>(a + 32 * 256);
        p0 = __builtin_amdgcn_mfma_f32_32x32x16_bf16(b0, qr[d0], p0, 0, 0, 0);
        p1 = __builtin_amdgcn_mfma_f32_32x32x16_bf16(b1, qr[d0], p1, 0, 0, 0); }
}
template <int VB, bool SK>
__device__ __forceinline__ void pv_tile(f32x16* o, int vb0, bf16x8 pa0, bf16x8 pa1, bf16x8 pa2, bf16x8 pa3, bool act) {
    if (SK && !act) return;
#define TRRD(dst, off) asm volatile("ds_read_b64_tr_b16 %0, %1 offset:%2" : "=&v"(dst) : "v"(vb0), "i"(off) : "memory")
#define PV_D0(d0) do { s16x4 l0, l1, l2, l3, h0, h1, h2, h3; constexpr int b_ = VB * SHM_V + v_rd_off(d0, 0, 0);     \
        TRRD(l0, b_); TRRD(h0, b_ + 2048); TRRD(l1, b_ + 4096); TRRD(h1, b_ + 6144); TRRD(l2, b_ + 8192); TRRD(h2, b_ + 10240); TRRD(l3, b_ + 12288); TRRD(h3, b_ + 14336); \
        asm volatile("s_waitcnt lgkmcnt(0)" ::: "memory"); SBAR();                 \
        o[d0] = __builtin_amdgcn_mfma_f32_32x32x16_bf16(pa0, (bf16x8){l0[0], l0[1], l0[2], l0[3], h0[0], h0[1], h0[2], h0[3]}, o[d0], 0, 0, 0);   \
        o[d0] = __builtin_amdgcn_mfma_f32_32x32x16_bf16(pa1, (bf16x8){l1[0], l1[1], l1[2], l1[3], h1[0], h1[1], h1[2], h1[3]}, o[d0], 0, 0, 0);   \
        o[d0] = __builtin_amdgcn_mfma_f32_32x32x16_bf16(pa2, (bf16x8){l2[0], l2[1], l2[2], l2[3], h2[0], h2[1], h2[2], h2[3]}, o[d0], 0, 0, 0);   \
        o[d0] = __builtin_amdgcn_mfma_f32_32x32x16_bf16(pa3, (bf16x8){l3[0], l3[1], l3[2], l3[3], h3[0], h3[1], h3[2], h3[3]}, o[d0], 0, 0, 0); } while (0)
    PV_D0(0); PV_D0(1); PV_D0(2); PV_D0(3);
#undef PV_D0
#undef TRRD
}

template <class TIn, class TOut> struct BlockRef { const TIn* Q; const TIn* K; const TIn* V; TOut* O; const float* G; int P0; };
template <class TIn> struct Seam {
    bf16x8 qr[8];
    bf16x8 st_v0, st_v1, st_k0, st_k1; f32x4 sf0, sf1, sf2, sf3; float st_g, gt;
    f32x4 tq[16];
};
__device__ __forceinline__ int swa_jlo(int P0, int W) { const int lowk = P0 - W + 1; return lowk > 0 ? lowk / KVBLK : 0; }
#define ROW(p, k0, rr) ((p) + (size_t)((k0) + (rr)) * PITCH + sc)
#define VMW() asm volatile("s_waitcnt vmcnt(0)" ::: "memory")
#define VMWN(n) asm volatile("s_waitcnt vmcnt(%0)" :: "i"(n) : "memory")
#define SLOAD_H(Kp, Vp, Gp, k0) do { const char* kb_ = (const char*)(Kp) + (size_t)(k0) * (PITCH * 2); const char* vb_ = (const char*)(Vp) + (size_t)(k0) * (PITCH * 2); const unsigned vo_ = (unsigned)tid * 16u; \
                         if (wid == 0) S.st_g = *(const float*)((const char*)((Gp) + (k0)) + (vo_ >> 2));                                                    \
                         S.st_v0 = *(const bf16x8*)(vb_ + vo_); S.st_v1 = *(const bf16x8*)(vb_ + 8192 + vo_);                                                \
                         S.st_k0 = *(const bf16x8*)(kb_ + vo_); S.st_k1 = *(const bf16x8*)(kb_ + 8192 + vo_); } while (0)
#define SWRITE_HK(bf) do { if (wid == 0) ((float*)(K_lds + 2 * SHM_K + NW * 256))[(bf) * 64 + lane] = -S.st_g; *(bf16x8*)(K_lds + (bf) * SHM_K + kws) = S.st_k0; *(bf16x8*)(K_lds + (bf) * SHM_K + kws + 32 * 256) = S.st_k1; } while (0)
#define SWRITE_HV(bf) do { *(bf16x8*)(V_lds + (bf) * SHM_V + vst0) = S.st_v0; *(bf16x8*)(V_lds + (bf) * SHM_V + vst1) = S.st_v1; } while (0)
#define SWRITE_H(bf) do { SWRITE_HV(bf); SWRITE_HK(bf); } while (0)
#define SLOAD_F(p, k0) do { S.sf0 = *(const f32x4*)ROW(p, k0, sr); S.sf1 = *(const f32x4*)(ROW(p, k0, sr) + 4);                \
                            S.sf2 = *(const f32x4*)ROW(p, k0, 32 + sr); S.sf3 = *(const f32x4*)(ROW(p, k0, 32 + sr) + 4); } while (0)
#define SWRITE_KF(bf) do { *(bf16x8*)(K_lds + (bf) * SHM_K + kws) = pack8(S.sf0, S.sf1); *(bf16x8*)(K_lds + (bf) * SHM_K + kws + 32 * 256) = pack8(S.sf2, S.sf3); } while (0)
#define SWRITE_VF(bf) do { *(bf16x8*)(V_lds + (bf) * SHM_V + vst0) = pack8(S.sf0, S.sf1); *(bf16x8*)(V_lds + (bf) * SHM_V + vst1) = pack8(S.sf2, S.sf3); } while (0)
template <class TIn, class TOut>
__device__ __forceinline__ void causal_swa_prime(const BlockRef<TIn, TOut>& cur, int W, char* lds, Seam<TIn>& S) {
    constexpr bool F32 = same_t<TIn, float>::v;
    int tid_ = threadIdx.x; asm volatile("" : "+v"(tid_)); const int tid = tid_, wid = __builtin_amdgcn_readfirstlane(tid >> 6), lane = tid & 63, r32 = lane & 31, hi = lane >> 5;
    const int sr = tid >> 4, sc = (tid & 15) * 8, kws = KSWZ(sr, sc * 2); char* K_lds = lds + 2 * SHM_V;
    const int kb0 = ((cur.P0 + QB - 1) / KVBLK) * KVBLK;
    for (int d0 = 0; d0 < 8; ++d0) S.qr[d0] = load8<TIn>(cur.Q + (size_t)(wid * QBLK + r32) * PITCH + d0 * 16 + hi * 8);
    S.gt = 0.f;
    if constexpr (F32) { SLOAD_F((const float*)cur.K, kb0); VMW(); SWRITE_KF(0); SBAR(); SLOAD_F((const float*)cur.V, kb0); }
    else { SLOAD_H(cur.K, cur.V, cur.G, kb0); VMW(); SWRITE_HK(0); }
    __syncthreads();
}
template <class TIn, class TOut, bool NB = false>
__device__ __forceinline__ void causal_swa_block(const BlockRef<TIn, TOut>& cur, const BlockRef<TIn, TOut>& nxt, int skv, int W, char* lds, Seam<TIn>& S) {
    constexpr bool F32 = same_t<TIn, float>::v;
    int tid_ = threadIdx.x; asm volatile("" : "+v"(tid_)); const int tid = tid_, wid = __builtin_amdgcn_readfirstlane(tid >> 6), lane = tid & 63, r32 = lane & 31, hi = lane >> 5;
    const int j_lo = swa_jlo(cur.P0, W);
    int j_hi = (cur.P0 + QB - 1) / KVBLK + 1; if (j_hi > skv / KVBLK) j_hi = skv / KVBLK;
    const int NT = j_hi - j_lo;
    const int kbn = ((nxt.P0 + QB - 1) / KVBLK) * KVBLK;
    const int qlo = cur.P0 + wid * QBLK, qm = qlo + r32 - 4 * hi;
    char* V_lds = lds; char* K_lds = lds + 2 * SHM_V;
    float* ws = (float*)(lds + 2 * SHM_V + 2 * SHM_K) + wid * 64; float* li_l = ws, * al_l = ws + 32;
    float m_reg = -1e30f, l_reg = 0; f32x16 o[4] = {};
    const int sr = tid >> 4, sc = (tid & 15) * 8, vst0 = v_st(sr, sc), vst1 = v_st(32 + sr, sc), kws = KSWZ(sr, sc * 2);
    const int vb0 = (int)(uintptr_t)V_lds + v_rd_base(lane);
    const TIn* Kh = cur.K; const TIn* Vh = cur.V; const float* Gh = cur.G; const float* g_lds = (const float*)(K_lds + 2 * SHM_K + NW * 256);
#define RESC(a) do { if (__any((a) < 1.f)) { if (hi == 0) al_l[r32] = (a); asm volatile("s_waitcnt lgkmcnt(0)" ::: "memory");              \
                     for (int d_ = 0; d_ < 4; ++d_) for (int r = 0; r < 16; ++r) o[d_][r] *= al_l[crow(r, hi)]; } } while (0)
#define KBASE(t) ((j_hi - 1 - (t)) * KVBLK)
#define ACT(t) (KBASE(t) <= qlo + QBLK - 1 && KBASE(t) + KVBLK - 1 >= qlo - W + 1)
#define MASKT(P0_, P1_, t) do { const int kb_ = KBASE(t); if ((!SK || ACT(t)) && (kb_ + KVBLK - 1 > qlo || kb_ <= qlo + QBLK - 1 - W)) mask_tile(P0_, P1_, qm - kb_, (unsigned)W); } while (0)
    constexpr int NQL = F32 ? 16 : 8;
    constexpr bool SK = WSKIP && !F32;
#define SEAM_K0() do { VMWN(NQL); if constexpr (F32) { SWRITE_KF(0); SBAR(); SLOAD_F((const float*)nxt.V, kbn); } else { SWRITE_HK(0); } SBAR(); } while (0)
    f32x16 pA0, pA1, pB0, pB1; float mnA, mnB, alA, alB; bf16x8 pa0, pa1, pa2, pa3;
    if constexpr (F32) { VMW(); SWRITE_VF(0); SBAR(); } else { SWRITE_HV(0); SBAR(); }
    if (NT > 1) { if constexpr (F32) SLOAD_F((const float*)Kh, KBASE(1)); else SLOAD_H(Kh, Vh, Gh, KBASE(1)); }
    SBAR(); qkt<0, SK, NB>(pA0, pA1, K_lds, r32, hi, S.qr, ACT(0), g_lds, S.gt);
    if constexpr (F32) { if (NT > 1) { VMW(); SWRITE_KF(1); SBAR(); SLOAD_F((const float*)Vh, KBASE(1)); } }
    MASKT(pA0, pA1, 0); partialSM(pA0, pA1, m_reg, mnA, alA);
    if (NT > 1) { VMW(); if constexpr (F32) { SWRITE_VF(1); SBAR(); if (NT > 2) SLOAD_F((const float*)Kh, KBASE(2)); } else SWRITE_H(1); }
    __syncthreads();
#define HALF_STEP(PX0, PX1, mnX, alX, PY0, PY1, alY, t, KB, VB, SB) do {                                                      \
        SBAR(); qkt<KB, SK, NB>(PX0, PX1, K_lds, r32, hi, S.qr, ACT(t), g_lds, S.gt);                                             \
        finishSM(PY0, PY1, alY, l_reg, pa0, pa1, pa2, pa3); SBAR();                                                           \
        if ((t) + 1 < NT) { if constexpr (F32) { VMW(); SWRITE_KF(SB); SBAR(); SLOAD_F((const float*)Vh, KBASE((t) + 1)); }  \
                            else { SLOAD_H(Kh, Vh, Gh, KBASE((t) + 1)); } SBAR(); }                                               \
        pv_tile<VB, SK>(o, vb0, pa0, pa1, pa2, pa3, ACT((t) - 1)); MASKT(PX0, PX1, (t)); partialSM(PX0, PX1, m_reg, mnX, alX);                                        \
        __syncthreads();                                                                                                      \
        if ((t) + 1 < NT) { VMW(); if constexpr (F32) { SWRITE_VF(SB); SBAR(); if ((t) + 2 < NT) SLOAD_F((const float*)Kh, KBASE((t) + 2)); } \
                            else { SWRITE_H(SB); } }                                                                          \
        RESC(alX); __syncthreads(); } while (0)
    for (int t = 1; t + 1 < NT; t += 2) {
        HALF_STEP(pB0, pB1, mnB, alB, pA0, pA1, alA, t, 1, 0, 0);
        HALF_STEP(pA0, pA1, mnA, alA, pB0, pB1, alB, t + 1, 0, 1, 1);
    }
    const bool even = (NT & 1) == 0;
    if (even) { SBAR(); qkt<1, SK, NB>(pB0, pB1, K_lds, r32, hi, S.qr, ACT(NT - 1), g_lds, S.gt); SBAR(); }
#define QROW(e) (nxt.Q + (size_t)(wid * QBLK + r32) * PITCH + ((e) >> 1) * 16 + hi * 8 + ((e) & 1) * 4)
    if constexpr (F32) { SLOAD_F((const float*)nxt.K, kbn); SBAR();
#pragma unroll
        for (int e = 0; e < 8; ++e) S.tq[e] = *(const f32x4*)QROW(e); }
    else { SLOAD_H(nxt.K, nxt.V, nxt.G, kbn); SBAR();
#pragma unroll
        for (int d0 = 0; d0 < 8; ++d0) S.qr[d0] = load8<TIn>(nxt.Q + (size_t)(wid * QBLK + r32) * PITCH + d0 * 16 + hi * 8); }
    SBAR();
    finishSM(pA0, pA1, alA, l_reg, pa0, pa1, pa2, pa3); SBAR();
    if constexpr (F32) {
#pragma unroll
        for (int e = 8; e < 16; ++e) S.tq[e] = *(const f32x4*)QROW(e); SBAR(); }
#undef QROW
    pv_tile<0, SK>(o, vb0, pa0, pa1, pa2, pa3, ACT(even ? NT - 2 : NT - 1));
    if (even) { MASKT(pB0, pB1, NT - 1); partialSM(pB0, pB1, m_reg, mnB, alB); __syncthreads(); RESC(alB);
        finishSM(pB0, pB1, alB, l_reg, pa0, pa1, pa2, pa3); SBAR(); pv_tile<1, SK>(o, vb0, pa0, pa1, pa2, pa3, ACT(NT - 1)); }
    SBAR(); SEAM_K0();
    if (hi == 0) li_l[r32] = l_reg; asm volatile("s_waitcnt lgkmcnt(0)" ::: "memory");
    float rli[16];
#pragma unroll
    for (int r = 0; r < 16; ++r) rli[r] = __builtin_amdgcn_rcpf(li_l[crow(r, hi)]);
    TOut* Ow = cur.O + (size_t)(wid * QBLK) * OPITCH;
#pragma unroll
    for (int r = 0; r < 16; ++r) { const int orow = crow(r, hi);
#pragma unroll
        for (int d0 = 0; d0 < 4; ++d0) { const float v = o[d0][r] * rli[r];
            if constexpr (same_t<TOut, float>::v) { Ow[(size_t)orow * OPITCH + d0 * 32 + r32] = v; }
            else { const float vn = __shfl_xor(v, 1);
                   if ((r32 & 1) == 0) *(unsigned*)(Ow + (size_t)orow * OPITCH + d0 * 32 + r32) = cvtpk(v, vn); } } }
    if constexpr (F32) {
#pragma unroll
        for (int d0 = 0; d0 < 8; ++d0) S.qr[d0] = pack8(S.tq[2 * d0], S.tq[2 * d0 + 1]); }
    __syncthreads();
#undef RESC
#undef KBASE
#undef ACT
#undef MASKT
#undef SEAM_K0
#undef HALF_STEP
}
#undef ROW
#undef VMW
#undef VMWN
#undef SLOAD_H
#undef SWRITE_HK
#undef SWRITE_HV
#undef SWRITE_H
#undef SLOAD_F
#undef SWRITE_KF
#undef SWRITE_VF

}
#ifndef MK_ONE_LAUNCH
#define MK_ONE_LAUNCH 1
#endif
#define LAS __attribute__((address_space(3)))
typedef unsigned short bf16;
typedef float f32x4 __attribute__((ext_vector_type(4)));
typedef unsigned u32x4 __attribute__((ext_vector_type(4)));
typedef unsigned u32x2 __attribute__((ext_vector_type(2)));
typedef short bf16x8 __attribute__((ext_vector_type(8)));

constexpr int BATCH = 4, SEQ = 4096, DM = 2048, M = BATCH * SEQ, FFH = 5632, NMOD = 6, MODS = NMOD * DM, NBIN = 3 * DM + 16, NH = 16;
constexpr float EPS = 1e-6f;
constexpr int NWAVES = 8, NTHR = 512;
constexpr int LDS_BYTES = 153600;
constexpr int NPHASE = 16;

constexpr size_t MiB = 1u << 20;
constexpr size_t WS_CTL = 0, WS_MOD = 1 * MiB, ZERO_BYTES = 2 * MiB;
constexpr size_t WS_LOGF = 2 * MiB, WS_G = 3 * MiB, WS_WM = 4 * MiB;
constexpr size_t WS_WAIN = 8 * MiB, WS_WAOUT = 24 * MiB, WS_WBIN = 32 * MiB, WS_WBOUT = 56 * MiB, WS_WGU = 64 * MiB, WS_WDN = 152 * MiB;
constexpr size_t WS_H = 196 * MiB;
constexpr size_t WS_R1 = 260 * MiB;
constexpr size_t WS_RA = 452 * MiB;
constexpr size_t WS_X = 628 * MiB, WS_END = 756 * MiB;
constexpr size_t SZ_ACT = (size_t)M * DM * 2;

struct Args { const float* in[20]; float* out; unsigned char* ws; int ph_lo, ph_hi; };

#define LDS_WAIT() asm volatile("s_waitcnt lgkmcnt(0)" ::: "memory")
__device__ __forceinline__ unsigned pk_bf16(float lo, float hi) { unsigned r; asm volatile("v_cvt_pk_bf16_f32 %0, %1, %2" : "=v"(r) : "v"(lo), "v"(hi)); return r; }
__device__ __forceinline__ float bf_lo(unsigned w) { return __uint_as_float(w << 16); }
__device__ __forceinline__ float bf_hi(unsigned w) { return __uint_as_float(w & 0xffff0000u); }
__device__ __forceinline__ float wave_sum(float v) {
#pragma unroll
    for (int o = 1; o < 64; o <<= 1) v += __shfl_xor(v, o);
    return v;
}

typedef __attribute__((address_space(1))) unsigned gu32;
constexpr int CW_BAR = 4096;
constexpr int MISC_OFF = LDS_BYTES - 64;
#define XB_TMO      128
#define XB_XCNT(j)  (256  + 64 * (j))
#define XB_XSUB(j)  (1280 + 64 * (j))
#define XB_XGEN(j)  (2304 + 64 * (j))
#define XB_TOP      3328
#define XB_TOPGEN   3392
#define XCD_BAR_WORDS 3456
#define XB_SPIN_CAP (1u << 18)

__device__ __forceinline__ unsigned xb_ld(unsigned* p)              { return __hip_atomic_load(p, __ATOMIC_RELAXED, __HIP_MEMORY_SCOPE_AGENT); }
__device__ __forceinline__ unsigned xb_add(unsigned* p, unsigned v) { return __hip_atomic_fetch_add(p, v, __ATOMIC_RELAXED, __HIP_MEMORY_SCOPE_AGENT); }
__device__ __forceinline__ unsigned xb_xcc_id() { return (unsigned)__builtin_amdgcn_s_getreg((3 << 11) | 20) & 0xFu; }
#define XB_SPIN(cond, bar) do { unsigned _sp = 0; while (cond) { __builtin_amdgcn_s_sleep(1); \
    if ((++_sp & 255u) == 0u) { if (xb_ld(&(bar)[XB_TMO])) break; if (_sp > XB_SPIN_CAP) { atomicAdd(&(bar)[XB_TMO], 1u); break; } } } } while (0)

struct XcdBarrier {
    unsigned* bar; unsigned x;
    volatile LAS unsigned* st;
};

__device__ __forceinline__ XcdBarrier xcd_barrier_post(unsigned* bar, volatile LAS unsigned* st) {
    XcdBarrier b; b.bar = bar; b.x = xb_xcc_id(); b.st = st;
    if (threadIdx.x == 0) (void)xb_add(&bar[XB_XCNT(b.x)], 1u);
    return b;
}
__device__ __forceinline__ void xcd_barrier_complete(unsigned* bar, unsigned x, unsigned& nloc, unsigned& nx) {
    const unsigned G = gridDim.x * gridDim.y * gridDim.z;
    unsigned sum, cnt, mine, sp = 0u;
    for (;;) {
        sum = 0u; cnt = 0u; mine = 0u;
#pragma unroll
        for (unsigned j = 0; j < 16; ++j) { const unsigned c = xb_ld(&bar[XB_XCNT(j)]); sum += c; cnt += (c > 0u) ? 1u : 0u; mine = (j == x) ? c : mine; }
        if (sum == G) break;
        __builtin_amdgcn_s_sleep(1);
        if ((++sp & 255u) == 0u) { if (xb_ld(&bar[XB_TMO])) break; if (sp > XB_SPIN_CAP) { atomicAdd(&bar[XB_TMO], 1u); break; } }
    }
    nloc = mine > 0u ? mine : 1u; nx = cnt > 0u ? cnt : 1u;
}

__device__ __forceinline__ void xcd_barrier(const XcdBarrier& b) {
    asm volatile("s_waitcnt vmcnt(0)" ::: "memory");
    __syncthreads();
    if (threadIdx.x == 0) {
        unsigned* bar = b.bar;
        __builtin_amdgcn_s_waitcnt(0);
        unsigned nloc = b.st[0], nx = b.st[1];
        if (nloc == 0u) { xcd_barrier_complete(bar, b.x, nloc, nx); b.st[0] = nloc; b.st[1] = nx; }
        const unsigned old = xb_add(&bar[XB_XSUB(b.x)], 1u);
        const unsigned gen = old / nloc;
        if (old + 1u == (gen + 1u) * nloc) {
            __builtin_amdgcn_fence(__ATOMIC_RELEASE, "agent");
            asm volatile("s_waitcnt vmcnt(0)" ::: "memory");
            const unsigned og = xb_add(&bar[XB_TOP], 1u);
            const unsigned tg = og / nx;
            if (og + 1u == (tg + 1u) * nx) xb_add(&bar[XB_TOPGEN], 1u);
            else XB_SPIN(xb_ld(&bar[XB_TOPGEN]) == tg, bar);
            __builtin_amdgcn_fence(__ATOMIC_ACQUIRE, "agent");
            xb_add(&bar[XB_XGEN(b.x)], 1u);
            asm volatile("s_waitcnt vmcnt(0)" ::: "memory");
        } else {
            XB_SPIN(xb_ld(&bar[XB_XGEN(b.x)]) == gen, bar);
            __builtin_amdgcn_fence(__ATOMIC_ACQUIRE, "agent");
            asm volatile("s_waitcnt vmcnt(0)" ::: "memory");
        }
    }
    __syncthreads();
}

__device__ __forceinline__ void transpose_item(const float* __restrict__ W, int ldw, int Kd, bf16* __restrict__ WT, int k0, int n0, int drow0, LAS float* scr, int lane) {
    {   f32x4 v[8];
        const float* wp = W + (size_t)(k0 + (lane >> 3)) * ldw + n0 + (lane & 7) * 4;
#pragma unroll
        for (int i = 0; i < 8; ++i) v[i] = __builtin_nontemporal_load((const f32x4*)(wp + (size_t)(8 * i) * ldw));
#pragma unroll
        for (int i = 0; i < 8; ++i) { LAS float* d = scr + (8 * i + (lane >> 3)) * 33 + (lane & 7) * 4; d[0] = v[i].x; d[1] = v[i].y; d[2] = v[i].z; d[3] = v[i].w; } }
    LDS_WAIT(); asm volatile("" ::: "memory");
    const int c = lane & 7;
#pragma unroll
    for (int j = 0; j < 4; ++j) { const int n = (lane >> 3) + 8 * j; const LAS float* s = scr + (8 * c) * 33 + n;
        u32x4 o; o.x = pk_bf16(s[0 * 33], s[1 * 33]); o.y = pk_bf16(s[2 * 33], s[3 * 33]); o.z = pk_bf16(s[4 * 33], s[5 * 33]); o.w = pk_bf16(s[6 * 33], s[7 * 33]);
        *(u32x4*)(WT + (size_t)(drow0 + n) * Kd + k0 + 8 * c) = o; }
    LDS_WAIT(); asm volatile("" ::: "memory");
}

__device__ __forceinline__ void mod_task(int t, const LAS float* scl, const float* __restrict__ ada_w, const float* __restrict__ ada_b, float* mod, int lane) {
    const int i = t >> 10, rem = t & 1023, cc = (rem & 7) + 8 * ((rem >> 7) & 7), ks = (rem >> 3) & 15;
    const int col = cc * 192 + lane * 4; const bool on = lane < 48;
    f32x4 acc[4];
#pragma unroll
    for (int b = 0; b < 4; ++b) acc[b] = (f32x4){0.f, 0.f, 0.f, 0.f};
    const float* wp = ada_w + ((size_t)i * DM + ks * 128) * MODS + (on ? col : 0);
#pragma unroll 8
    for (int kk = 0; kk < 128; ++kk) {
        const f32x4 w = *(const f32x4*)(wp + (size_t)kk * MODS);
        const int k = ks * 128 + kk;
        const f32x4 sv = *(const LAS f32x4*)(scl + 4 * k);
        acc[0] += sv.x * w; acc[1] += sv.y * w; acc[2] += sv.z * w; acc[3] += sv.w * w;
    }
    if (on) {
        if (ks == 0) { const f32x4 bv = *(const f32x4*)(ada_b + (size_t)i * MODS + col);
#pragma unroll
            for (int b = 0; b < 4; ++b) acc[b] += bv; }
#pragma unroll
        for (int b = 0; b < 4; ++b) { float* mp = mod + ((size_t)i * BATCH + b) * MODS + col;
            atomicAdd(mp + 0, acc[b][0]); atomicAdd(mp + 1, acc[b][1]); atomicAdd(mp + 2, acc[b][2]); atomicAdd(mp + 3, acc[b][3]); }
    }
}

struct P0Ptrs { const float *a_w_in, *a_w_out, *b_w_in, *b_w_out, *w_gate, *w_up, *w_down, *a_w_s, *c, *ada_w, *ada_b; bf16 *WAin, *WAout, *WBin, *WBout, *Wgu, *Wdn, *Wm; float* mod; };
template <int ONLY = 0>
__device__ __forceinline__ void p0_prologue(LAS unsigned char* lds, const P0Ptrs& P, int vcu, int G, int tid, int wave, int lane) {
    LAS float* scr = (LAS float*)(lds + wave * 16384);
    const int gw = vcu * NWAVES + wave, NGW = G * NWAVES;
    {   LAS float* scl = (LAS float*)lds;
        for (int idx = tid; idx < BATCH * DM; idx += NTHR) { const int k = idx >> 2, b = idx & 3; const float cv = P.c[b * DM + k]; scl[idx] = cv / (1.0f + __expf(-cv)); }
        __syncthreads();
        for (int t = gw; t < 2048; t += NGW) mod_task(t, scl, P.ada_w, P.ada_b, P.mod, lane);
        __syncthreads(); }
    if (ONLY == 1) return;
    for (int idx = gw * 64 + lane; idx < NH * 128 * 128; idx += NGW * 64) { const int tt = (idx >> 7) & 127, s = idx & 127; P.Wm[idx] = (s <= tt) ? (bf16)(pk_bf16(P.a_w_s[idx], 0.f) & 0xffffu) : (bf16)0; }
    constexpr int I_AIN = 32 * 128, I_AOUT = 32 * 64, I_BIN = 32 * 192, I_BOUT = 32 * 64, I_G = 32 * 176, I_D = 88 * 64;
    constexpr int NITEMS = I_AIN + I_AOUT + I_BIN + I_BOUT + 4 * I_G + 2 * I_D;
    for (int it = gw; it < NITEMS; it += NGW) {
        int r = it;
        if (r < I_AIN) { const int kb = r / 128, nb = r % 128; transpose_item(P.a_w_in, 2 * DM, DM, P.WAin, 64 * kb, 32 * nb, 32 * nb, scr, lane); continue; } r -= I_AIN;
        if (r < I_AOUT) { const int kb = r / 64, nb = r % 64; transpose_item(P.a_w_out, DM, DM, P.WAout, 64 * kb, 32 * nb, 32 * nb, scr, lane); continue; } r -= I_AOUT;
        if (r < I_BIN) { const int kb = r / 192, nb = r % 192; transpose_item(P.b_w_in, NBIN, DM, P.WBin, 64 * kb, 32 * nb, 32 * nb, scr, lane); continue; } r -= I_BIN;
        if (r < I_BOUT) { const int kb = r / 64, nb = r % 64; transpose_item(P.b_w_out, DM, DM, P.WBout, 64 * kb, 32 * nb, 32 * nb, scr, lane); continue; } r -= I_BOUT;
        if (r < 4 * I_G) { const int which = r / I_G, rr = r % I_G, layer = which >> 1, isup = which & 1, kb = rr / 176, nb = rr % 176, n0 = 32 * nb;
            const float* W = (isup ? P.w_up : P.w_gate) + (size_t)layer * DM * FFH;
            transpose_item(W, FFH, DM, P.Wgu + (size_t)layer * 2 * FFH * DM, 64 * kb, n0, 256 * (n0 >> 7) + (n0 & 127) + 128 * isup, scr, lane); continue; } r -= 4 * I_G;
        { const int layer = r / I_D, rr = r % I_D, kb = rr / 64, nb = rr % 64;
            transpose_item(P.w_down + (size_t)layer * FFH * DM, DM, FFH, P.Wdn + (size_t)layer * DM * FFH, 64 * kb, 32 * nb, 32 * nb, scr, lane); }
    }
}

constexpr int WTP = DM + 4;
template <int MODE, bool INBF>
__device__ __forceinline__ void norm_phase(LAS unsigned char* lds, const void* __restrict__ xin_, const float* __restrict__ gvec, const float* shift, const float* scale,
                                           bf16* outb, float* outf, const float* __restrict__ wf, const float* __restrict__ bfv, float* logf_out, int tid, int wave, int lane) {
    LAS float* cA = (LAS float*)lds; LAS float* cB = cA + DM; LAS float* wT = (LAS float*)(lds + 16384);
    for (int blk = blockIdx.x; blk < M / 64; blk += gridDim.x) {
        const int b = (blk * 64) / SEQ;
        __syncthreads();
        for (int cidx = tid; cidx < DM; cidx += NTHR) { const float g = gvec[cidx];
            if (MODE != 1) { cA[cidx] = g * (1.0f + scale[(size_t)b * MODS + cidx]); cB[cidx] = shift[(size_t)b * MODS + cidx]; } else { cA[cidx] = g; cB[cidx] = 0.f; } }
        if (MODE == 2 && blk == (int)blockIdx.x) {
            for (int idx = tid; idx < DM * 16; idx += NTHR) { const int k = idx >> 4, hh = idx & 15; wT[hh * WTP + k] = wf[(size_t)k * NBIN + 3 * DM + hh]; } }
        __syncthreads();
        constexpr int RB = (MODE == 2) ? 2 : 1;
        for (int i0 = 0; i0 < 8; i0 += RB) {
            f32x4 v[RB][8];
#pragma unroll
            for (int q = 0; q < RB; ++q) { const int row = blk * 64 + wave + 8 * (i0 + q);
                if (INBF) { const u32x2* xr = (const u32x2*)((const bf16*)xin_ + (size_t)row * DM) + lane;
#pragma unroll
                    for (int j = 0; j < 8; ++j) { const u32x2 w = xr[64 * j]; v[q][j] = (f32x4){bf_lo(w.x), bf_hi(w.x), bf_lo(w.y), bf_hi(w.y)}; }
                } else { const f32x4* xr = (const f32x4*)((const float*)xin_ + (size_t)row * DM) + lane;
#pragma unroll
                    for (int j = 0; j < 8; ++j) v[q][j] = xr[64 * j]; } }
#pragma unroll
            for (int q = 0; q < RB; ++q) { const int row = blk * 64 + wave + 8 * (i0 + q); float ss = 0.f;
#pragma unroll
                for (int j = 0; j < 8; ++j) ss += (v[q][j].x * v[q][j].x + v[q][j].y * v[q][j].y) + (v[q][j].z * v[q][j].z + v[q][j].w * v[q][j].w);
                const float rstd = 1.0f / sqrtf(wave_sum(ss) * (1.0f / DM) + EPS);
#pragma unroll
                for (int j = 0; j < 8; ++j) { const f32x4 a = *(const LAS f32x4*)(cA + 4 * (64 * j + lane)), bb = *(const LAS f32x4*)(cB + 4 * (64 * j + lane)); v[q][j] = (v[q][j] * rstd) * a + bb; }
                if (MODE == 1) { f32x4* o = (f32x4*)(outf + (size_t)row * DM) + lane;
#pragma unroll
                    for (int j = 0; j < 8; ++j) o[64 * j] = v[q][j];
                } else { u32x2* o = (u32x2*)(outb + (size_t)row * DM) + lane;
#pragma unroll
                    for (int j = 0; j < 8; ++j) { u32x2 w; w.x = pk_bf16(v[q][j].x, v[q][j].y); w.y = pk_bf16(v[q][j].z, v[q][j].w); o[64 * j] = w; } } }
            if (MODE == 2) {
                float mine[RB];
#pragma unroll
                for (int q = 0; q < RB; ++q) mine[q] = 0.f;
#pragma unroll 2
                for (int hh = 0; hh < 16; ++hh) { float a[RB];
#pragma unroll
                    for (int q = 0; q < RB; ++q) a[q] = 0.f;
#pragma unroll
                    for (int j = 0; j < 8; ++j) { const f32x4 w = *(const LAS f32x4*)(wT + hh * WTP + 4 * (64 * j + lane));
#pragma unroll
                        for (int q = 0; q < RB; ++q) a[q] += (v[q][j].x * w.x + v[q][j].y * w.y) + (v[q][j].z * w.z + v[q][j].w * w.w); }
#pragma unroll
                    for (int q = 0; q < RB; ++q) { const float s = wave_sum(a[q]); mine[q] = (lane == hh) ? s : mine[q]; } }
#pragma unroll
                for (int q = 0; q < RB; ++q) if (lane < 16) { const int row = blk * 64 + wave + 8 * (i0 + q); const float xx = mine[q] + bfv[lane]; const float lf = fminf(xx, 0.f) - log1pf(expf(-fabsf(xx))); logf_out[(size_t)row * 16 + lane] = lf; }
            }
        }
    }
}

__device__ __forceinline__ void cumsum_phase(LAS unsigned char* lds, const float* logf, float* Gout, int tid, int wave, int lane) {
    LAS float* wt = (LAS float*)lds;
    for (int bh = blockIdx.x; bh < BATCH * NH; bh += gridDim.x) {
        const int b = bh >> 4, h = bh & 15; float v[8]; float run = 0.f;
#pragma unroll
        for (int e = 0; e < 8; ++e) { run += logf[((size_t)b * SEQ + tid * 8 + e) * 16 + h]; v[e] = run; }
        float inc = run;
#pragma unroll
        for (int o = 1; o < 64; o <<= 1) { const float t = __shfl_up(inc, o); if (lane >= o) inc += t; }
        __syncthreads();
        if (lane == 63) wt[wave] = inc;
        __syncthreads();
        float off = inc - run;
#pragma unroll
        for (int w = 0; w < NWAVES; ++w) off += (w < wave) ? wt[w] : 0.f;
        float* gp = Gout + (size_t)bh * SEQ + tid * 8;
#pragma unroll
        for (int e = 0; e < 8; ++e) gp[e] = (off + v[e]) * 11.313708498984761f;
    }
    __syncthreads();
}

constexpr int VTP = 136;
__device__ __forceinline__ void sgu_phase(LAS unsigned char* lds, const bf16* __restrict__ U, const bf16* __restrict__ V, bf16* __restrict__ Y, const bf16* __restrict__ Wm,
                                          const float* __restrict__ ln_g, const float* __restrict__ ln_b, const float* __restrict__ b_s, int tid, int wave, int lane) {
    LAS float* st = (LAS float*)lds; LAS bf16* VT = (LAS bf16*)(lds + 1024);
    for (int unit = blockIdx.x; unit < (M / 128) * 2; unit += gridDim.x) {
        const int chunk = unit >> 1, half = unit & 1, row0 = chunk * 128;
        __syncthreads();
        for (int rb = 0; rb < 16; rb += 4) { u32x4 sw[4][4];
#pragma unroll
            for (int q = 0; q < 4; ++q) { const u32x4* vp = (const u32x4*)(V + (size_t)(row0 + wave * 16 + rb + q) * DM) + lane;
#pragma unroll
                for (int j = 0; j < 4; ++j) sw[q][j] = vp[64 * j]; }
#pragma unroll
            for (int q = 0; q < 4; ++q) { const int rl = wave * 16 + rb + q; float s = 0.f, qq = 0.f;
#pragma unroll
                for (int j = 0; j < 4; ++j) { const u32x4 w = sw[q][j];
                    const float x0 = bf_lo(w.x), x1 = bf_hi(w.x), x2 = bf_lo(w.y), x3 = bf_hi(w.y), x4 = bf_lo(w.z), x5 = bf_hi(w.z), x6 = bf_lo(w.w), x7 = bf_hi(w.w);
                    s += ((x0 + x1) + (x2 + x3)) + ((x4 + x5) + (x6 + x7)); qq += ((x0 * x0 + x1 * x1) + (x2 * x2 + x3 * x3)) + ((x4 * x4 + x5 * x5) + (x6 * x6 + x7 * x7)); }
                s = wave_sum(s); qq = wave_sum(qq); const float mean = s * (1.0f / DM); const float var = fmaxf(qq * (1.0f / DM) - mean * mean, 0.f);
                if (lane == 0) { st[2 * rl] = mean; st[2 * rl + 1] = 1.0f / sqrtf(var + EPS); } } }
        __syncthreads();
        const int srow = wave * 16 + (lane & 15), t0 = wave * 16, nks = (wave >> 1) + 1, tq = t0 + (lane & 15);
        const size_t rowoff = (size_t)(row0 + tq) * DM;
        u32x4 vr[4];
#pragma unroll
        for (int i = 0; i < 4; ++i) vr[i] = *(const u32x4*)(V + (size_t)(row0 + srow) * DM + (half * 8) * 128 + ((lane >> 4) + 4 * i) * 8);
        for (int gi = 0; gi < 8; ++gi) {
            const int g = half * 8 + gi;
            bf16x8 af[4]; u32x2 uw[8];
#pragma unroll
            for (int ks = 0; ks < 4; ++ks) af[ks] = *(const bf16x8*)(Wm + ((size_t)(g * 128 + tq) * 128 + ks * 32 + 8 * (lane >> 4)));
#pragma unroll
            for (int n = 0; n < 8; ++n) uw[n] = *(const u32x2*)(U + rowoff + g * 128 + n * 16 + 4 * (lane >> 4));
            const float bs = b_s[g * 128 + tq];
            {   const float mean = st[2 * srow], rstd = st[2 * srow + 1];
#pragma unroll
                for (int i = 0; i < 4; ++i) { const int cc = (lane >> 4) + 4 * i, col = g * 128 + cc * 8; const u32x4 w = vr[i];
                    const f32x4 g0 = *(const f32x4*)(ln_g + col), g1 = *(const f32x4*)(ln_g + col + 4), b0 = *(const f32x4*)(ln_b + col), b1 = *(const f32x4*)(ln_b + col + 4);
                    LAS bf16* vt = VT + (cc * 8) * VTP + srow;
                    vt[0 * VTP] = (bf16)pk_bf16((bf_lo(w.x) - mean) * rstd * g0.x + b0.x, 0.f); vt[1 * VTP] = (bf16)pk_bf16((bf_hi(w.x) - mean) * rstd * g0.y + b0.y, 0.f);
                    vt[2 * VTP] = (bf16)pk_bf16((bf_lo(w.y) - mean) * rstd * g0.z + b0.z, 0.f); vt[3 * VTP] = (bf16)pk_bf16((bf_hi(w.y) - mean) * rstd * g0.w + b0.w, 0.f);
                    vt[4 * VTP] = (bf16)pk_bf16((bf_lo(w.z) - mean) * rstd * g1.x + b1.x, 0.f); vt[5 * VTP] = (bf16)pk_bf16((bf_hi(w.z) - mean) * rstd * g1.y + b1.y, 0.f);
                    vt[6 * VTP] = (bf16)pk_bf16((bf_lo(w.w) - mean) * rstd * g1.z + b1.z, 0.f); vt[7 * VTP] = (bf16)pk_bf16((bf_hi(w.w) - mean) * rstd * g1.w + b1.w, 0.f); } }
            __syncthreads();
            if (gi + 1 < 8) {
#pragma unroll
                for (int i = 0; i < 4; ++i) vr[i] = *(const u32x4*)(V + (size_t)(row0 + srow) * DM + (g + 1) * 128 + ((lane >> 4) + 4 * i) * 8); }
            f32x4 acc[8];
#pragma unroll
            for (int n = 0; n < 8; ++n) acc[n] = (f32x4){0.f, 0.f, 0.f, 0.f};
#pragma unroll
            for (int ks = 0; ks < 4; ++ks) { if (ks < nks) {
#pragma unroll
                for (int n = 0; n < 8; ++n) { const bf16x8 bv = *(const LAS bf16x8*)(VT + (n * 16 + (lane & 15)) * VTP + ks * 32 + 8 * (lane >> 4));
                    acc[n] = __builtin_amdgcn_mfma_f32_16x16x32_bf16(bv, af[ks], acc[n], 0, 0, 0); } } }
#pragma unroll
            for (int n = 0; n < 8; ++n) { const int col = g * 128 + n * 16 + 4 * (lane >> 4); u32x2 yw;
                yw.x = pk_bf16(bf_lo(uw[n].x) * (acc[n][0] + bs), bf_hi(uw[n].x) * (acc[n][1] + bs)); yw.y = pk_bf16(bf_lo(uw[n].y) * (acc[n][2] + bs), bf_hi(uw[n].y) * (acc[n][3] + bs));
                *(u32x2*)(Y + rowoff + col) = yw; }
            __syncthreads();
        }
    }
}

__device__ __forceinline__ fox::BlockRef<bf16, bf16> attn_ref(int L, int pass, const bf16* Q, const bf16* K, const bf16* V, bf16* O, const float* G) {
    const int bh = L >> 3, x = L & 7, qb = pass ? 15 - x : x, b = bh >> 4, h = bh & 15;
    fox::BlockRef<bf16, bf16> r; const size_t koff = (size_t)bh * SEQ * fox::PITCH, qoff = koff + (size_t)qb * fox::QB * fox::PITCH, ooff = ((size_t)b * SEQ + (size_t)qb * fox::QB) * fox::OPITCH + h * 128;
    r.Q = Q + qoff; r.O = O + ooff; r.K = K + koff; r.V = V + koff; r.G = G + (size_t)bh * SEQ; r.P0 = qb * fox::QB;
    return r;
}
template <bool NB = false>
__device__ __forceinline__ void attn_phase(char* lds, const bf16* Q, const bf16* K, const bf16* V, bf16* O, const float* G, int vcu, int nwg) {
    constexpr int total = BATCH * NH * 8;
    int L = vcu; if (L >= total) return;
    int pass = 0;
    fox::BlockRef<bf16, bf16> cur = attn_ref(L, 0, Q, K, V, O, G);
    fox::Seam<bf16> S;
    fox::causal_swa_prime<bf16, bf16>(cur, SEQ, lds, S);
    for (;;) {
        const bool more_pass = pass == 0, more_item = L + nwg < total, last = !more_pass && !more_item;
        int passn = pass + 1, Ln = L;
        if (!more_pass) { passn = 0; Ln = more_item ? L + nwg : L; }
        const fox::BlockRef<bf16, bf16> nxt = last ? cur : attn_ref(Ln, passn, Q, K, V, O, G);
        fox::causal_swa_block<bf16, bf16, NB>(cur, nxt, SEQ, SEQ, lds, S);
        if (last) break;
        cur = nxt; pass = passn; L = Ln;
    }
}

__global__ void __launch_bounds__(NTHR, 2) fwd_kernel(Args args) {
    extern __shared__ __attribute__((aligned(16))) unsigned char lds_raw[];
    LAS unsigned char* lds = (LAS unsigned char*)lds_raw;
    const int G = gridDim.x;
#define INP(i) ((const float*)ka[i])
#define FRESH() int tid = threadIdx.x; asm volatile("" : "+v"(tid)); const int lane = tid & 63, wave = __builtin_amdgcn_readfirstlane(tid >> 6); int bx = blockIdx.x; asm volatile("" : "+s"(bx)); const int vcu = (G % 8 == 0) ? (bx % 8) * (G / 8) + bx / 8 : bx; (void)lane; (void)wave; (void)vcu; const __attribute__((address_space(4))) unsigned long long* ka = (const __attribute__((address_space(4))) unsigned long long*)__builtin_amdgcn_kernarg_segment_ptr(); asm volatile("" : "+s"(ka)); unsigned char* ws = (unsigned char*)ka[21]; const float* x = INP(0); float* mod = (float*)(ws + WS_MOD); float* logf_b = (float*)(ws + WS_LOGF); float* Gb = (float*)(ws + WS_G); bf16* Wm = (bf16*)(ws + WS_WM); bf16* WAin = (bf16*)(ws + WS_WAIN); bf16* WAout = (bf16*)(ws + WS_WAOUT); bf16* WBin = (bf16*)(ws + WS_WBIN); bf16* WBout = (bf16*)(ws + WS_WBOUT); bf16* Wgu = (bf16*)(ws + WS_WGU); bf16* Wdn = (bf16*)(ws + WS_WDN); bf16* Hb = (bf16*)(ws + WS_H); bf16* R1 = (bf16*)(ws + WS_R1); bf16* RA = (bf16*)(ws + WS_RA); bf16* XA = (bf16*)(ws + WS_X); float* XF = (float*)(ws + WS_R1);    (void)x; (void)mod; (void)logf_b; (void)Gb; (void)Wm; (void)WAin; (void)WAout; (void)WBin; (void)WBout; (void)Wgu; (void)Wdn; (void)Hb; (void)R1; (void)RA; (void)XA; (void)XF;
    unsigned char* ws0 = args.ws;
    const int lo = MK_ONE_LAUNCH ? 0 : args.ph_lo, hi = MK_ONE_LAUNCH ? NPHASE : args.ph_hi;
    if (threadIdx.x < 16) ((LAS unsigned*)(lds + MISC_OFF))[threadIdx.x] = 0u;
    __syncthreads();
    XcdBarrier bar = xcd_barrier_post((unsigned*)(ws0 + WS_CTL) + CW_BAR, (volatile LAS unsigned*)(lds + MISC_OFF));
    int ph = 0;
#define IN_PH() (lo <= ph && ph < hi)
#ifdef PROBE_BAR2
#define PROBE_BAR_EXTRA xcd_barrier(bar);
#else
#define PROBE_BAR_EXTRA
#endif
#define SEAM() do { if (IN_PH() && ph + 1 < hi) { if (ph == 0 && args.ph_lo < 0) cg::this_grid().sync(); else { xcd_barrier(bar); PROBE_BAR_EXTRA } } ++ph; } while (0)

    if (IN_PH()) { FRESH();
        P0Ptrs P; P.a_w_in = INP(6); P.a_w_out = INP(12); P.b_w_in = INP(13); P.b_w_out = INP(15); P.w_gate = INP(16); P.w_up = INP(17); P.w_down = INP(18);
        P.a_w_s = INP(10); P.c = INP(1); P.ada_w = INP(2); P.ada_b = INP(3);
        P.WAin = WAin; P.WAout = WAout; P.WBin = WBin; P.WBout = WBout; P.Wgu = Wgu; P.Wdn = Wdn; P.Wm = Wm; P.mod = mod;
        p0_prologue(lds, P, vcu, G, tid, wave, lane);
#ifdef PROBE_P02
        __syncthreads(); P.mod = (float*)(ws + WS_RA); p0_prologue(lds, P, vcu, G, tid, wave, lane); __syncthreads(); p0_prologue(lds, P, vcu, G, tid, wave, lane);
#endif
    }
    SEAM();
    { constexpr int layer = 0;
#undef modl
#define modl (mod + (size_t)layer * BATCH * MODS)
        if (IN_PH()) { FRESH();
            if (layer == 0) { norm_phase<0, false>(lds, x, INP(4), modl, modl + DM, Hb, nullptr, nullptr, nullptr, nullptr, tid, wave, lane);
#ifdef PROBE_NORM2
            __syncthreads(); norm_phase<0, false>(lds, x, INP(4), modl, modl + DM, Hb, nullptr, nullptr, nullptr, nullptr, tid, wave, lane);
#endif
            }
            else { norm_phase<2, true>(lds, XA, INP(4) + DM, modl, modl + DM, Hb, nullptr, INP(13), INP(14), logf_b, tid, wave, lane);
#if defined(PROBE_NORM2) || defined(PROBE_NORM2M)
            __syncthreads(); norm_phase<2, true>(lds, XA, INP(4) + DM, modl, modl + DM, Hb, nullptr, INP(13), INP(14), logf_b, tid, wave, lane);
#endif
            }
        }
        SEAM();
        if (IN_PH()) { FRESH();
            if (layer == 0) {
                pg8::Gemm g{Hb, WAin, M, 2 * DM, DM}; pg8::StaticOrder S; S.init(M, 2 * DM, G, bx);
                pg8::EpiBf16<1> E{R1, DM, INP(7), DM, SZ_ACT / 2, 1.f};
                pg8::gemm_phase<pg8::EpiBf16<1>, pg8::StaticOrder, PG8_ALIGN, PG8_SP2>(lds, g, S, E);
            } else {
                cumsum_phase(lds, logf_b, Gb, tid, wave, lane);
                pg8::Gemm g{Hb, WBin, M, 3 * DM, DM}; pg8::StaticOrder S; S.init(M, 3 * DM, G, bx);
                pg8::EpiQKV E{R1, SZ_ACT / 2, SEQ, NH};
                pg8::gemm_phase<pg8::EpiQKV, pg8::StaticOrder, PG8_ALIGN, PG8_SP2>(lds, g, S, E);
            }
        }
        SEAM();
        if (IN_PH()) { FRESH();
            if (layer == 0) sgu_phase(lds, R1, R1 + SZ_ACT / 2, R1 + SZ_ACT, Wm, INP(8), INP(9), INP(11), tid, wave, lane);
#ifdef PROBE_SGU2
            if (layer == 0) { xcd_barrier(bar); sgu_phase(lds, R1, R1 + SZ_ACT / 2, R1 + SZ_ACT, Wm, INP(8), INP(9), INP(11), tid, wave, lane); }
#endif
            else attn_phase((char*)lds_raw, R1, R1 + SZ_ACT / 2, R1 + SZ_ACT, RA, Gb, vcu, G);
#ifdef PROBE_ATT2
            if (layer == 1) { xcd_barrier(bar); attn_phase<true>((char*)lds_raw, R1, R1 + SZ_ACT / 2, R1 + SZ_ACT, RA + SZ_ACT / 2, Gb, vcu, G); }
#endif
        }
        SEAM();
        if (IN_PH()) { FRESH();
            pg8::Gemm g{(layer == 0) ? (const bf16*)(R1 + SZ_ACT) : (const bf16*)RA, (layer == 0) ? WAout : WBout, M, DM, DM}; pg8::StaticOrder S; S.init(M, DM, G, bx);
            if (layer == 0) { pg8::EpiRes2<float, bf16> E{x, XA, DM, modl + 2 * DM, MODS, SEQ}; pg8::gemm_phase<pg8::EpiRes2<float, bf16>, pg8::StaticOrder, PG8_ALIGN, PG8_SP2>(lds, g, S, E); }
            else { pg8::EpiRes2<bf16, bf16> E{XA, XA, DM, modl + 2 * DM, MODS, SEQ}; pg8::gemm_phase<pg8::EpiRes2<bf16, bf16>, pg8::StaticOrder, PG8_ALIGN, PG8_SP2>(lds, g, S, E); }
        }
        SEAM();
        if (IN_PH()) { FRESH(); norm_phase<0, true>(lds, XA, INP(5) + (size_t)layer * DM, modl + 3 * DM, modl + 4 * DM, Hb, nullptr, nullptr, nullptr, nullptr, tid, wave, lane);
#ifdef PROBE_NORM2
            __syncthreads(); norm_phase<0, true>(lds, XA, INP(5) + (size_t)layer * DM, modl + 3 * DM, modl + 4 * DM, Hb, nullptr, nullptr, nullptr, nullptr, tid, wave, lane);
#endif
 }
        SEAM();
        if (IN_PH()) { FRESH();
            pg8::Gemm g{Hb, Wgu + (size_t)layer * 2 * FFH * DM, M, 2 * FFH, DM}; pg8::StaticOrder S; S.init(M, 2 * FFH, G, bx);
            pg8::EpiSwiGLU E{RA, FFH};
            pg8::gemm_phase<pg8::EpiSwiGLU, pg8::StaticOrder, PG8_ALIGN, PG8_SP2>(lds, g, S, E);
#ifdef PROBE_GU2
            if (layer == 0) { xcd_barrier(bar); pg8::gemm_phase<pg8::EpiSwiGLU, pg8::StaticOrder, PG8_ALIGN, PG8_SP2>(lds, g, S, E); }
#endif
        }
        SEAM();
        if (IN_PH()) { FRESH();
            pg8::Gemm g{RA, Wdn + (size_t)layer * DM * FFH, M, DM, FFH}; pg8::StaticOrder S; S.init(M, DM, G, bx);
            if (layer == 0) { pg8::EpiRes2<bf16, bf16> E{XA, XA, DM, modl + 5 * DM, MODS, SEQ}; pg8::gemm_phase<pg8::EpiRes2<bf16, bf16>, pg8::StaticOrder, PG8_ALIGN, PG8_SP2>(lds, g, S, E); }
            else { pg8::EpiRes2<bf16, float> E{XA, XF, DM, modl + 5 * DM, MODS, SEQ}; pg8::gemm_phase<pg8::EpiRes2<bf16, float>, pg8::StaticOrder, PG8_ALIGN, PG8_SP2>(lds, g, S, E); }
        }
        SEAM();
        }
    { constexpr int layer = 1;
#undef modl
#define modl (mod + (size_t)layer * BATCH * MODS)
        if (IN_PH()) { FRESH();
            if (layer == 0) { norm_phase<0, false>(lds, x, INP(4), modl, modl + DM, Hb, nullptr, nullptr, nullptr, nullptr, tid, wave, lane);
#ifdef PROBE_NORM2
            __syncthreads(); norm_phase<0, false>(lds, x, INP(4), modl, modl + DM, Hb, nullptr, nullptr, nullptr, nullptr, tid, wave, lane);
#endif
            }
            else { norm_phase<2, true>(lds, XA, INP(4) + DM, modl, modl + DM, Hb, nullptr, INP(13), INP(14), logf_b, tid, wave, lane);
#if defined(PROBE_NORM2) || defined(PROBE_NORM2M)
            __syncthreads(); norm_phase<2, true>(lds, XA, INP(4) + DM, modl, modl + DM, Hb, nullptr, INP(13), INP(14), logf_b, tid, wave, lane);
#endif
            }
        }
        SEAM();
        if (IN_PH()) { FRESH();
            if (layer == 0) {
                pg8::Gemm g{Hb, WAin, M, 2 * DM, DM}; pg8::StaticOrder S; S.init(M, 2 * DM, G, bx);
                pg8::EpiBf16<1> E{R1, DM, INP(7), DM, SZ_ACT / 2, 1.f};
                pg8::gemm_phase<pg8::EpiBf16<1>, pg8::StaticOrder, PG8_ALIGN, PG8_SP2>(lds, g, S, E);
            } else {
                cumsum_phase(lds, logf_b, Gb, tid, wave, lane);
                pg8::Gemm g{Hb, WBin, M, 3 * DM, DM}; pg8::StaticOrder S; S.init(M, 3 * DM, G, bx);
                pg8::EpiQKV E{R1, SZ_ACT / 2, SEQ, NH};
                pg8::gemm_phase<pg8::EpiQKV, pg8::StaticOrder, PG8_ALIGN, PG8_SP2>(lds, g, S, E);
            }
        }
        SEAM();
        if (IN_PH()) { FRESH();
            if (layer == 0) sgu_phase(lds, R1, R1 + SZ_ACT / 2, R1 + SZ_ACT, Wm, INP(8), INP(9), INP(11), tid, wave, lane);
#ifdef PROBE_SGU2
            if (layer == 0) { xcd_barrier(bar); sgu_phase(lds, R1, R1 + SZ_ACT / 2, R1 + SZ_ACT, Wm, INP(8), INP(9), INP(11), tid, wave, lane); }
#endif
            else attn_phase((char*)lds_raw, R1, R1 + SZ_ACT / 2, R1 + SZ_ACT, RA, Gb, vcu, G);
#ifdef PROBE_ATT2
            if (layer == 1) { xcd_barrier(bar); attn_phase<true>((char*)lds_raw, R1, R1 + SZ_ACT / 2, R1 + SZ_ACT, RA + SZ_ACT / 2, Gb, vcu, G); }
#endif
        }
        SEAM();
        if (IN_PH()) { FRESH();
            pg8::Gemm g{(layer == 0) ? (const bf16*)(R1 + SZ_ACT) : (const bf16*)RA, (layer == 0) ? WAout : WBout, M, DM, DM}; pg8::StaticOrder S; S.init(M, DM, G, bx);
            if (layer == 0) { pg8::EpiRes2<float, bf16> E{x, XA, DM, modl + 2 * DM, MODS, SEQ}; pg8::gemm_phase<pg8::EpiRes2<float, bf16>, pg8::StaticOrder, PG8_ALIGN, PG8_SP2>(lds, g, S, E); }
            else { pg8::EpiRes2<bf16, bf16> E{XA, XA, DM, modl + 2 * DM, MODS, SEQ}; pg8::gemm_phase<pg8::EpiRes2<bf16, bf16>, pg8::StaticOrder, PG8_ALIGN, PG8_SP2>(lds, g, S, E); }
        }
        SEAM();
        if (IN_PH()) { FRESH(); norm_phase<0, true>(lds, XA, INP(5) + (size_t)layer * DM, modl + 3 * DM, modl + 4 * DM, Hb, nullptr, nullptr, nullptr, nullptr, tid, wave, lane);
#ifdef PROBE_NORM2
            __syncthreads(); norm_phase<0, true>(lds, XA, INP(5) + (size_t)layer * DM, modl + 3 * DM, modl + 4 * DM, Hb, nullptr, nullptr, nullptr, nullptr, tid, wave, lane);
#endif
 }
        SEAM();
        if (IN_PH()) { FRESH();
            pg8::Gemm g{Hb, Wgu + (size_t)layer * 2 * FFH * DM, M, 2 * FFH, DM}; pg8::StaticOrder S; S.init(M, 2 * FFH, G, bx);
            pg8::EpiSwiGLU E{RA, FFH};
            pg8::gemm_phase<pg8::EpiSwiGLU, pg8::StaticOrder, PG8_ALIGN, PG8_SP2>(lds, g, S, E);
#ifdef PROBE_GU2
            if (layer == 0) { xcd_barrier(bar); pg8::gemm_phase<pg8::EpiSwiGLU, pg8::StaticOrder, PG8_ALIGN, PG8_SP2>(lds, g, S, E); }
#endif
        }
        SEAM();
        if (IN_PH()) { FRESH();
            pg8::Gemm g{RA, Wdn + (size_t)layer * DM * FFH, M, DM, FFH}; pg8::StaticOrder S; S.init(M, DM, G, bx);
            if (layer == 0) { pg8::EpiRes2<bf16, bf16> E{XA, XA, DM, modl + 5 * DM, MODS, SEQ}; pg8::gemm_phase<pg8::EpiRes2<bf16, bf16>, pg8::StaticOrder, PG8_ALIGN, PG8_SP2>(lds, g, S, E); }
            else { pg8::EpiRes2<bf16, float> E{XA, XF, DM, modl + 5 * DM, MODS, SEQ}; pg8::gemm_phase<pg8::EpiRes2<bf16, float>, pg8::StaticOrder, PG8_ALIGN, PG8_SP2>(lds, g, S, E); }
        }
        SEAM();
        }
    if (IN_PH()) { FRESH(); norm_phase<1, false>(lds, XF, INP(19), nullptr, nullptr, nullptr, (float*)ka[20], nullptr, nullptr, nullptr, tid, wave, lane);
#ifdef PROBE_NORM2
            __syncthreads(); norm_phase<1, false>(lds, XF, INP(19), nullptr, nullptr, nullptr, (float*)ka[20], nullptr, nullptr, nullptr, tid, wave, lane);
#endif
 }
#undef IN_PH
#undef SEAM
}

extern "C" void kernel_launch(void* const* d_in, const int* in_sizes, int n_in, void* d_out, int out_size, void* d_ws, size_t ws_size, hipStream_t stream) {
    static int grid = 0;
    if (grid == 0) {
        if (n_in != 20 || in_sizes[0] != M * DM || out_size != M * DM || ws_size < WS_END) { fprintf(stderr, "kernel_launch: unexpected shapes (n_in %d, in0 %d, out %d, ws %zu)\n", n_in, n_in > 0 ? in_sizes[0] : -1, out_size, ws_size); grid = -1; return; }
        int dev = 0, cus = 0, per_cu = 0;
        (void)hipGetDevice(&dev); (void)hipDeviceGetAttribute(&cus, hipDeviceAttributeMultiprocessorCount, dev);
        if (hipFuncSetAttribute((const void*)fwd_kernel, hipFuncAttributeMaxDynamicSharedMemorySize, LDS_BYTES) != hipSuccess) { fprintf(stderr, "kernel_launch: hipFuncSetAttribute failed\n"); grid = -1; return; }
        if (hipOccupancyMaxActiveBlocksPerMultiprocessor(&per_cu, (const void*)fwd_kernel, NTHR, LDS_BYTES) != hipSuccess || per_cu < 1) { fprintf(stderr, "kernel_launch: occupancy query says %d\n", per_cu); per_cu = 1; }
        (void)hipGetLastError();
        grid = cus > 0 ? cus : 256;
        fprintf(stderr, "kernel_launch: grid %d (cus %d, per_cu %d)\n", grid, cus, per_cu);
    }
    if (grid < 0) return;
    (void)hipMemsetAsync((char*)d_ws + WS_CTL, 0, ZERO_BYTES, stream);
    Args a{};
    for (int i = 0; i < 20; ++i) a.in[i] = (const float*)d_in[i];
    a.out = (float*)d_out; a.ws = (unsigned char*)d_ws;
#if MK_ONE_LAUNCH
    a.ph_lo = 0; a.ph_hi = NPHASE;
    void* kargs[] = {&a};
    hipError_t e = hipLaunchCooperativeKernel((const void*)fwd_kernel, dim3(grid), dim3(NTHR), kargs, LDS_BYTES, stream);
    if (e != hipSuccess) fprintf(stderr, "kernel_launch: cooperative launch failed: %s (grid %d)\n", hipGetErrorString(e), grid);
#else
    for (int p = 0; p < NPHASE; ++p) { a.ph_lo = p; a.ph_hi = p + 1; hipLaunchKernelGGL(fwd_kernel, dim3(grid), dim3(NTHR), LDS_BYTES, stream, a); }
#endif
}
```

```cpp
#include <hip/hip_runtime.h>
#include <hip/hip_cooperative_groups.h>
#include <cstdio>
#include <cstdint>
namespace cg = cooperative_groups;
#ifndef PG8_WGM
#define PG8_WGM 4
#endif
namespace pg8 {
#define PG8_LAS __attribute__((address_space(3)))
typedef unsigned short bf16_t;
typedef short bf16x8 __attribute__((ext_vector_type(8)));
typedef float f32x4 __attribute__((ext_vector_type(4)));
typedef unsigned u32x4 __attribute__((ext_vector_type(4)));
constexpr int BM = 256, BK = 64, HALF = 128, HTB = HALF * BK * 2  , STAGE_BYTES = 8 * HTB, NXCD = 8, WGM = PG8_WGM;

__host__ __device__ __forceinline__ int lds_byte(int r, int c) { const int st = (r >> 4) * 2 + (c >> 5), rr = r & 15, cc = c & 31, ob = rr * 64 + cc * 2; return st * 1024 + (ob ^ (((ob >> 9) & 1) << 5)); }
__host__ __device__ __forceinline__ void stage_rc(int b, int& R, int& C) { const int st = b / 1024, sb = b % 1024, swz = sb ^ (((sb >> 9) & 1) << 5); R = (st >> 1) * 16 + swz / 64; C = (st & 1) * 32 + (swz % 64) / 2; }
__host__ __device__ __forceinline__ int perm32(int rho) { const int n = rho >> 4, i = rho & 15; return 8 * (i >> 2) + 4 * n + (i & 3); }

struct Unit { int pm, pn; };
struct Gemm { const bf16_t* A; const bf16_t* Bt; int M, N, K; };

struct StaticOrder {
    int nM, nN, nwg, G, c;
    __host__ __device__ void init(int M, int N, int G_, int c_) { nM = M / BM; nN = N / BM; nwg = nM * nN; G = G_; c = c_; }
    __host__ __device__ bool next(int i, Unit& u) const {
        const long L = (long)i * G + c; if (L >= nwg) return false;
        int wgid = (int)L; { const int q = nwg / NXCD, r = nwg % NXCD, xcd = wgid % NXCD, off = wgid / NXCD; wgid = (xcd < r ? xcd * (q + 1) : r * (q + 1) + (xcd - r) * q) + off; }
        const int nig = WGM * nN, gid = wgid / nig, fm = gid * WGM, gsz = (nM - fm) < WGM ? (nM - fm) : WGM;
        u.pm = fm + ((wgid % nig) % gsz); u.pn = (wgid % nig) / gsz;
        if (gid & 1) u.pn = nN - 1 - u.pn;
        return true;
    }
    __device__ __forceinline__ void a_ready(const Unit&) const {}
    __device__ __forceinline__ void done(const Unit&) const {}
};

__device__ __forceinline__ unsigned cvt_pk_bf16(float lo, float hi) { unsigned r; asm volatile("v_cvt_pk_bf16_f32 %0, %1, %2" : "=v"(r) : "v"(lo), "v"(hi)); return r; }
typedef float f32x2 __attribute__((ext_vector_type(2)));
__device__ __forceinline__ f32x2 gelu_pk(f32x2 v) {
    const f32x2 av = __builtin_elementwise_abs(v), d = av * 0.2316418882f + 1.0f;
    f32x2 t; t.x = __builtin_amdgcn_rcpf(d.x); t.y = __builtin_amdgcn_rcpf(d.y);
    f32x2 q = t * 0.5307027145f + (-0.7265760135f); q = q * t + 0.7107068705f; q = q * t + (-0.142248368f); q = q * t + 0.127414796f; q = q * t;
    const f32x2 s = (v * v) * (-0.72134752044f);
    f32x2 e; e.x = __builtin_amdgcn_exp2f(s.x); e.y = __builtin_amdgcn_exp2f(s.y);
    const f32x2 m = v * (q * e), r = v - m;
    f32x2 o; o.x = v.x < 0.f ? m.x : r.x; o.y = v.y < 0.f ? m.y : r.y; return o;
}

template <int ACT  > struct EpiBf16 {
    static constexpr bool PERM = true, AFTER_DRAIN = false; static_assert(ACT == 0 || ACT == 1, "EpiBf16: ACT is 0 (none) or 1 (gelu_pk)");
    bf16_t* O; int ldc; const float* bias; int split_cols; size_t split_stride; float scale0;
    __device__ __forceinline__ void operator()(const f32x4 (&acc)[2][2][4][2], const Unit& u, int wr, int wc, int fr, int fq) const {
        const int row0 = u.pm * BM + wr * 64 + fr; int colt = u.pn * BM; bf16_t* base = O;
        float sc = 1.f; if (split_cols) { const int t = colt / split_cols; base += (size_t)t * split_stride; colt -= t * split_cols; if (t == 0) sc = scale0; }
        const int col0 = colt + wc * 32 + 8 * fq, bcol0 = u.pn * BM + wc * 32 + 8 * fq;
        f32x4 bv[2][2];
#pragma unroll
        for (int bj = 0; bj < 2; ++bj)
#pragma unroll
            for (int n = 0; n < 2; ++n) bv[bj][n] = bias ? *(const f32x4*)(bias + bcol0 + bj * HALF + 4 * n) : (f32x4){0.f, 0.f, 0.f, 0.f};
#pragma unroll
        for (int ai = 0; ai < 2; ++ai)
#pragma unroll
            for (int m = 0; m < 4; ++m) { bf16_t* rowp = base + (size_t)(row0 + ai * HALF + m * 16) * ldc + col0;
#pragma unroll
                for (int bj = 0; bj < 2; ++bj) { f32x4 v0 = acc[ai][bj][m][0] + bv[bj][0], v1 = acc[ai][bj][m][1] + bv[bj][1];
                    if (ACT == 1) { f32x2 a = gelu_pk((f32x2){v0[0], v0[1]}), b = gelu_pk((f32x2){v0[2], v0[3]}), c = gelu_pk((f32x2){v1[0], v1[1]}), d = gelu_pk((f32x2){v1[2], v1[3]});
                        v0 = (f32x4){a.x, a.y, b.x, b.y}; v1 = (f32x4){c.x, c.y, d.x, d.y}; }
                    v0 = v0 * sc; v1 = v1 * sc; u32x4 w; w.x = cvt_pk_bf16(v0[0], v0[1]); w.y = cvt_pk_bf16(v0[2], v0[3]); w.z = cvt_pk_bf16(v1[0], v1[1]); w.w = cvt_pk_bf16(v1[2], v1[3]);
                    *(u32x4*)(rowp + bj * HALF) = w; } }
    }
};
template <class Epi, class Sched, bool ALIGN_EPI = false, bool SP2 = false>
__device__ __forceinline__ void gemm_phase(PG8_LAS unsigned char* lds, const Gemm g, const Sched& S, const Epi& E) {
    int tid_ = threadIdx.x; asm volatile("" : "+v"(tid_)); const int tid = tid_, wid = __builtin_amdgcn_readfirstlane(tid >> 6), lane = tid & 63, wr = wid >> 2, wc = wid & 3, fr = lane & 15, fq = lane >> 4;
    const int K = g.K, nt = K / BK;
    unsigned voffA[2], voffB[2];
#pragma unroll
    for (int i = 0; i < 2; ++i) { int R, C; stage_rc(tid * 16 + i * 8192, R, C); const int Rb = Epi::PERM ? ((R & ~31) + perm32(R & 31)) : R;
        voffA[i] = (unsigned)(R * K + C) * 2u; voffB[i] = (unsigned)(Rb * K + C) * 2u; }
    const size_t kstep = (size_t)(BK * 2);
    const size_t hstep = (size_t)HALF * K * 2;
    const size_t tstep = 2 * hstep;
    const unsigned ldsw = (unsigned)wid * 1024u;
    const int aoff = lds_byte(wr * 64 + fr, fq * 8), boff = lds_byte(wc * 32 + fr, fq * 8);
#define PG8_SA(b, h) (((b) * 2 + (h)) * HTB)
#define PG8_SB(b, h) ((4 + (b) * 2 + (h)) * HTB)
#define PG8_STAGE(bufoff, gbase, voff) do { _Pragma("unroll") for (int _i = 0; _i < 2; ++_i) \
        __builtin_amdgcn_global_load_lds((const unsigned*)((const char*)(gbase) + (voff)[_i]), (PG8_LAS unsigned*)(lds + (bufoff) + ldsw + _i * 8192), 16, 0, 0); } while (0)
#define PG8_LDA(dst, b, h) do { _Pragma("unroll") for (int m = 0; m < 4; ++m) _Pragma("unroll") for (int k = 0; k < 2; ++k) dst[m][k] = *(const PG8_LAS bf16x8*)(lds + PG8_SA(b, h) + aoff + m * 2048 + k * 1024); } while (0)
#define PG8_LDB(dst, b, h) do { _Pragma("unroll") for (int n = 0; n < 2; ++n) _Pragma("unroll") for (int k = 0; k < 2; ++k) dst[n][k] = *(const PG8_LAS bf16x8*)(lds + PG8_SB(b, h) + boff + n * 2048 + k * 1024); } while (0)
#define PG8_MMA(ai, bj, At, Bt) do { __builtin_amdgcn_s_setprio(1); _Pragma("unroll") for (int m = 0; m < 4; ++m) _Pragma("unroll") for (int n = 0; n < 2; ++n) _Pragma("unroll") for (int k = 0; k < 2; ++k) \
        acc[ai][bj][m][n] = __builtin_amdgcn_mfma_f32_16x16x32_bf16(Bt[n][k], At[m][k], acc[ai][bj][m][n], 0, 0, 0); __builtin_amdgcn_s_setprio(0); } while (0)
#define PG8_WAIT_V(n) asm volatile("s_waitcnt vmcnt(" #n ")" ::: "memory")
#define PG8_WAIT_L(n) asm volatile("s_waitcnt lgkmcnt(" #n ")" ::: "memory")
#define PG8_BAR __builtin_amdgcn_s_barrier()
#define PG8_SCHED __builtin_amdgcn_sched_barrier(0)
    Unit cur, nxt; int ui = 0;
    if (!S.next(0, cur)) return;
    f32x4 acc[2][2][4][2];
#pragma unroll
    for (int a = 0; a < 2; ++a)
#pragma unroll
        for (int b = 0; b < 2; ++b)
#pragma unroll
            for (int m = 0; m < 4; ++m)
#pragma unroll
                for (int n = 0; n < 2; ++n) acc[a][b][m][n] = (f32x4){0.f, 0.f, 0.f, 0.f};
    bf16x8 At[4][2], B0[2][2], B1[2][2];
    const char* cA = (const char*)g.A + (size_t)cur.pm * tstep; const char* cB = (const char*)g.Bt + (size_t)cur.pn * tstep;
    S.a_ready(cur);
    if constexpr (SP2) {
        PG8_STAGE(PG8_SB(0, 0), cB, voffB); PG8_STAGE(PG8_SB(0, 1), cB + hstep, voffB); PG8_STAGE(PG8_SA(0, 0), cA, voffA); PG8_STAGE(PG8_SA(0, 1), cA + hstep, voffA);
        if (wr == 1) PG8_BAR;
        PG8_WAIT_V(2); PG8_BAR;
        PG8_STAGE(PG8_SB(1, 0), cB + kstep, voffB); PG8_STAGE(PG8_SA(1, 0), cA + kstep, voffA); PG8_STAGE(PG8_SB(1, 1), cB + hstep + kstep, voffB);
        PG8_WAIT_V(6); PG8_BAR;
    } else {
        PG8_STAGE(PG8_SB(0, 0), cB, voffB); PG8_STAGE(PG8_SA(0, 0), cA, voffA); PG8_STAGE(PG8_SB(0, 1), cB + hstep, voffB); PG8_STAGE(PG8_SA(0, 1), cA + hstep, voffA);
        if (wr == 1) PG8_BAR;
        PG8_WAIT_V(4); PG8_BAR;
        PG8_STAGE(PG8_SB(1, 0), cB + kstep, voffB); PG8_STAGE(PG8_SA(1, 0), cA + kstep, voffA); PG8_STAGE(PG8_SB(1, 1), cB + hstep + kstep, voffB);
        PG8_WAIT_V(6); PG8_BAR;
    }
    for (;;) {
        const bool has_next = S.next(ui + 1, nxt);
        const char* nA = has_next ? (const char*)g.A + (size_t)nxt.pm * tstep : cA; const char* nB = has_next ? (const char*)g.Bt + (size_t)nxt.pn * tstep : cB;
        for (int t = 0; t < nt; t += 2) {
            const bool last = (t == nt - 2);
            const char* a1 = cA + (size_t)(t + 1) * kstep;
            const char* a2 = last ? nA : cA + (size_t)(t + 2) * kstep; const char* b2 = last ? nB : cB + (size_t)(t + 2) * kstep;
            const char* a3 = a2 + kstep; const char* b3 = b2 + kstep;
            if (last && has_next) S.a_ready(nxt);
            if constexpr (SP2) {
            PG8_LDB(B0, 0, 0); PG8_LDB(B1, 0, 1); PG8_SCHED; PG8_LDA(At, 0, 0); PG8_STAGE(PG8_SA(1, 1), a1 + hstep, voffA);
            PG8_WAIT_V(8); PG8_WAIT_L(0); PG8_BAR; PG8_MMA(0, 0, At, B0); PG8_MMA(0, 1, At, B1); PG8_BAR; PG8_SCHED;
            PG8_LDA(At, 0, 1); PG8_STAGE(PG8_SB(0, 0), b2, voffB); PG8_STAGE(PG8_SB(0, 1), b2 + hstep, voffB); PG8_STAGE(PG8_SA(0, 0), a2, voffA);
            PG8_WAIT_V(8); PG8_WAIT_L(0); PG8_BAR; PG8_MMA(1, 0, At, B0); PG8_MMA(1, 1, At, B1); PG8_BAR; PG8_SCHED;
            PG8_LDB(B0, 1, 0); PG8_LDB(B1, 1, 1); PG8_SCHED; PG8_LDA(At, 1, 0); PG8_STAGE(PG8_SA(0, 1), a2 + hstep, voffA);
            PG8_WAIT_V(8); PG8_WAIT_L(0); PG8_BAR; PG8_MMA(0, 0, At, B0); PG8_MMA(0, 1, At, B1); PG8_BAR; PG8_SCHED;
            PG8_LDA(At, 1, 1); PG8_STAGE(PG8_SB(1, 0), b3, voffB); PG8_STAGE(PG8_SB(1, 1), b3 + hstep, voffB); PG8_STAGE(PG8_SA(1, 0), a3, voffA);
            PG8_WAIT_V(8); PG8_WAIT_L(0); PG8_BAR; PG8_MMA(1, 0, At, B0); PG8_MMA(1, 1, At, B1); PG8_BAR; PG8_SCHED;
            } else {
            PG8_LDB(B0, 0, 0); PG8_SCHED; PG8_LDA(At, 0, 0); PG8_STAGE(PG8_SA(1, 1), a1 + hstep, voffA);
            PG8_WAIT_L(8); PG8_BAR; PG8_WAIT_L(0); PG8_MMA(0, 0, At, B0); PG8_BAR; PG8_SCHED;
            PG8_LDB(B1, 0, 1); PG8_STAGE(PG8_SB(0, 0), b2, voffB);
            PG8_BAR; PG8_WAIT_L(0); PG8_MMA(0, 1, At, B1); PG8_BAR;
            PG8_LDA(At, 0, 1); PG8_STAGE(PG8_SA(0, 0), a2, voffA);
            PG8_BAR; PG8_WAIT_L(0); PG8_MMA(1, 0, At, B0); PG8_BAR; PG8_SCHED;
            PG8_STAGE(PG8_SB(0, 1), b2 + hstep, voffB);
            PG8_WAIT_V(6); PG8_BAR; PG8_MMA(1, 1, At, B1); PG8_BAR;
            PG8_LDB(B0, 1, 0); PG8_SCHED; PG8_LDA(At, 1, 0); PG8_STAGE(PG8_SA(0, 1), a2 + hstep, voffA);
            PG8_WAIT_L(8); PG8_BAR; PG8_WAIT_L(0); PG8_MMA(0, 0, At, B0); PG8_BAR; PG8_SCHED;
            PG8_LDB(B1, 1, 1); PG8_STAGE(PG8_SB(1, 0), b3, voffB);
            PG8_BAR; PG8_WAIT_L(0); PG8_MMA(0, 1, At, B1); PG8_BAR;
            PG8_LDA(At, 1, 1); PG8_STAGE(PG8_SA(1, 0), a3, voffA);
            PG8_BAR; PG8_WAIT_L(0); PG8_MMA(1, 0, At, B0); PG8_BAR; PG8_SCHED;
            PG8_STAGE(PG8_SB(1, 1), b3 + hstep, voffB);
            PG8_WAIT_V(6); PG8_BAR; PG8_MMA(1, 1, At, B1); PG8_BAR;
            }
        }
        if constexpr (ALIGN_EPI) { if (wr == 0) PG8_BAR; }
        if constexpr (!Epi::AFTER_DRAIN) { E(acc, cur, wr, wc, fr, fq); S.done(cur); }
        if (!has_next) break;
#pragma unroll
        for (int a = 0; a < 2; ++a)
#pragma unroll
            for (int b = 0; b < 2; ++b)
#pragma unroll
                for (int m = 0; m < 4; ++m)
#pragma unroll
                    for (int n = 0; n < 2; ++n) acc[a][b][m][n] = (f32x4){0.f, 0.f, 0.f, 0.f};
        cur = nxt; cA = nA; cB = nB; ++ui;
        if constexpr (ALIGN_EPI) { if (wr == 1) PG8_BAR; }
    }
    PG8_WAIT_V(0);
    if constexpr (!ALIGN_EPI) { if (wr == 0) PG8_BAR; }
    PG8_BAR;
    if constexpr (Epi::AFTER_DRAIN) { E.fused(acc, cur, wr, wc, fr, fq, lds, wid, lane); S.done(cur); }
#undef PG8_SA
#undef PG8_SB
#undef PG8_STAGE
#undef PG8_LDA
#undef PG8_LDB
#undef PG8_MMA
#undef PG8_WAIT_V
#undef PG8_WAIT_L
#undef PG8_BAR
#undef PG8_SCHED
}
}
namespace pg8 {
struct EpiRes {
    static constexpr bool PERM = false, AFTER_DRAIN = false;
    const float* res; float* out; int ldc; const float* gate; int gate_stride; int rows_per_batch;
    __device__ __forceinline__ void operator()(const f32x4 (&acc)[2][2][4][2], const Unit& u, int wr, int wc, int fr, int fq) const {
        const int row0 = u.pm * BM + wr * 64 + fr, col0 = u.pn * BM + wc * 32 + 4 * fq;
        const float* gp = gate + (size_t)((u.pm * BM) / rows_per_batch) * gate_stride + col0;
        f32x4 gv[2][2];
#pragma unroll
        for (int bj = 0; bj < 2; ++bj)
#pragma unroll
            for (int n = 0; n < 2; ++n) gv[bj][n] = *(const f32x4*)(gp + bj * HALF + n * 16);
#pragma unroll
        for (int ai = 0; ai < 2; ++ai)
#pragma unroll
            for (int m = 0; m < 4; ++m) { const size_t off = (size_t)(row0 + ai * HALF + m * 16) * ldc + col0;
#pragma unroll
                for (int bj = 0; bj < 2; ++bj)
#pragma unroll
                    for (int n = 0; n < 2; ++n) { const f32x4 r = *(const f32x4*)(res + off + bj * HALF + n * 16); *(f32x4*)(out + off + bj * HALF + n * 16) = r + gv[bj][n] * acc[ai][bj][m][n]; }
                asm volatile("" ::: "memory"); }
    }
};
template <class TI, class TO> struct EpiRes2 {
    static constexpr bool PERM = true, AFTER_DRAIN = false;
    const TI* res; TO* out; int ldc; const float* gate; int gate_stride; int rows_per_batch;
    __device__ __forceinline__ void operator()(const f32x4 (&acc)[2][2][4][2], const Unit& u, int wr, int wc, int fr, int fq) const {
        const int row0 = u.pm * BM + wr * 64 + fr, col0 = u.pn * BM + wc * 32 + 8 * fq;
        const float* gp = gate + (size_t)((u.pm * BM) / rows_per_batch) * gate_stride + col0;
        f32x4 gv[2][2];
#pragma unroll
        for (int bj = 0; bj < 2; ++bj)
#pragma unroll
            for (int n = 0; n < 2; ++n) gv[bj][n] = *(const f32x4*)(gp + bj * HALF + 4 * n);
#pragma unroll
        for (int ai = 0; ai < 2; ++ai)
#pragma unroll
            for (int m = 0; m < 4; ++m) { const size_t off = (size_t)(row0 + ai * HALF + m * 16) * ldc + col0;
#pragma unroll
                for (int bj = 0; bj < 2; ++bj) { f32x4 r0, r1;
                    if constexpr (sizeof(TI) == 4) { r0 = *(const f32x4*)((const float*)res + off + bj * HALF); r1 = *(const f32x4*)((const float*)res + off + bj * HALF + 4); }
                    else { const u32x4 w = *(const u32x4*)((const bf16_t*)res + off + bj * HALF);
                        r0 = (f32x4){__uint_as_float(w.x << 16), __uint_as_float(w.x & 0xffff0000u), __uint_as_float(w.y << 16), __uint_as_float(w.y & 0xffff0000u)};
                        r1 = (f32x4){__uint_as_float(w.z << 16), __uint_as_float(w.z & 0xffff0000u), __uint_as_float(w.w << 16), __uint_as_float(w.w & 0xffff0000u)}; }
                    const f32x4 o0 = r0 + gv[bj][0] * acc[ai][bj][m][0], o1 = r1 + gv[bj][1] * acc[ai][bj][m][1];
                    if constexpr (sizeof(TO) == 4) { *(f32x4*)((float*)out + off + bj * HALF) = o0; *(f32x4*)((float*)out + off + bj * HALF + 4) = o1; }
                    else { u32x4 w; w.x = cvt_pk_bf16(o0[0], o0[1]); w.y = cvt_pk_bf16(o0[2], o0[3]); w.z = cvt_pk_bf16(o1[0], o1[1]); w.w = cvt_pk_bf16(o1[2], o1[3]); *(u32x4*)((bf16_t*)out + off + bj * HALF) = w; } }
                asm volatile("" ::: "memory"); }
    }
};
struct EpiSwiGLU {
    static constexpr bool PERM = true, AFTER_DRAIN = false;
    bf16_t* O; int ldc;
    __device__ __forceinline__ static float act(float g, float u) { return g * __builtin_amdgcn_rcpf(1.0f + __builtin_amdgcn_exp2f(g * -1.4426950408889634f)) * u; }
    __device__ __forceinline__ void operator()(const f32x4 (&acc)[2][2][4][2], const Unit& u, int wr, int wc, int fr, int fq) const {
        const int row0 = u.pm * BM + wr * 64 + fr, col0 = u.pn * HALF + wc * 32 + 8 * fq;
#pragma unroll
        for (int ai = 0; ai < 2; ++ai)
#pragma unroll
            for (int m = 0; m < 4; ++m) { bf16_t* rowp = O + (size_t)(row0 + ai * HALF + m * 16) * ldc + col0;
                const f32x4 g0 = acc[ai][0][m][0], g1 = acc[ai][0][m][1], u0 = acc[ai][1][m][0], u1 = acc[ai][1][m][1];
                u32x4 w; w.x = cvt_pk_bf16(act(g0[0], u0[0]), act(g0[1], u0[1])); w.y = cvt_pk_bf16(act(g0[2], u0[2]), act(g0[3], u0[3]));
                w.z = cvt_pk_bf16(act(g1[0], u1[0]), act(g1[1], u1[1])); w.w = cvt_pk_bf16(act(g1[2], u1[2]), act(g1[3], u1[3]));
                *(u32x4*)rowp = w; }
    }
};
struct EpiQKV {
    static constexpr bool PERM = true, AFTER_DRAIN = false;
    bf16_t* O; size_t tensor_stride; int seq, nheads;
    __device__ __forceinline__ void operator()(const f32x4 (&acc)[2][2][4][2], const Unit& u, int wr, int wc, int fr, int fq) const {
        const int row0 = u.pm * BM + wr * 64 + fr; const int colt = u.pn * BM; const int t = colt / (nheads * 128), head0 = (colt - t * nheads * 128) >> 7;
        const int b = (u.pm * BM) / seq, s0 = row0 - b * seq;
        bf16_t* base = O + (size_t)t * tensor_stride + ((size_t)(b * nheads + head0) * seq + s0) * 128 + wc * 32 + 8 * fq;
#pragma unroll
        for (int ai = 0; ai < 2; ++ai)
#pragma unroll
            for (int m = 0; m < 4; ++m) {
#pragma unroll
                for (int bj = 0; bj < 2; ++bj) { const f32x4 v0 = acc[ai][bj][m][0], v1 = acc[ai][bj][m][1];
                    u32x4 w; w.x = cvt_pk_bf16(v0[0], v0[1]); w.y = cvt_pk_bf16(v0[2], v0[3]); w.z = cvt_pk_bf16(v1[0], v1[1]); w.w = cvt_pk_bf16(v1[2], v1[3]);
                    *(u32x4*)(base + ((size_t)bj * seq + ai * HALF + m * 16) * 128) = w; } }
    }
};
}
#ifndef PG8_SP2
#define PG8_SP2 true
#endif
#ifndef PG8_ALIGN
#define PG8_ALIGN true
#endif
namespace fox {
constexpr int D = 128, PITCH = 128, OPITCH = 2048;
constexpr float SCALE = 0.08838834764831845f;
constexpr float THR = 8.f;
constexpr bool WSKIP = false;
constexpr int NW = 8, QBLK = 32, KVBLK = 64, QB = NW * QBLK;
constexpr int SHM_V = KVBLK * D * 2, SHM_K = KVBLK * D * 2;
constexpr int LDS_BYTES = 2 * SHM_V + 2 * SHM_K + NW * 64 * 4 + 2 * 64 * 4;
using bf16 = unsigned short;
typedef short bf16x8 __attribute__((ext_vector_type(8)));
typedef short s16x4 __attribute__((ext_vector_type(4)));
typedef float f32x16 __attribute__((ext_vector_type(16)));
typedef float f32x4 __attribute__((ext_vector_type(4)));
typedef unsigned u32x4 __attribute__((ext_vector_type(4)));
template <class A, class Bt> struct same_t { static constexpr bool v = false; };
template <class A> struct same_t<A, A> { static constexpr bool v = true; };

#define KSWZ(row, colB) ((row) * 256 + ((colB) ^ (((row) & 7) << 4)))
#define SBAR() __builtin_amdgcn_sched_barrier(0)
__device__ __forceinline__ int v_st(int k, int c) { const int kk = (k & ~0xC) | ((k & 4) << 1) | ((k & 8) >> 1); return ((kk >> 3) * 4 + (c >> 5)) * 512 + ((kk & 7) * 32 + (c & 31)) * 2; }
__device__ __forceinline__ int v_rd_base(int lane) { return ((lane & 3) << 3) | (((lane >> 2) & 3) << 6) | (((lane >> 4) & 1) << 5) | (((lane >> 5) & 1) << 8); }
constexpr int v_rd_off(int d0, int ks, int half) { return d0 * 512 + ks * 4096 + half * 2048; }
__device__ __forceinline__ int crow(int r, int hi) { return (r & 3) + 8 * (r >> 2) + 4 * hi; }
__device__ __forceinline__ unsigned cvtpk(float lo, float hi) {
    unsigned r; asm volatile("v_cvt_pk_bf16_f32 %0, %1, %2" : "=v"(r) : "v"(lo), "v"(hi)); return r;
}
__device__ __forceinline__ bf16x8 pack8(f32x4 a, f32x4 b) {
    u32x4 w = {cvtpk(a[0], a[1]), cvtpk(a[2], a[3]), cvtpk(b[0], b[1]), cvtpk(b[2], b[3])};
    return *reinterpret_cast<bf16x8*>(&w);
}
template <class T> __device__ __forceinline__ bf16x8 load8(const T* p) {
    if constexpr (same_t<T, float>::v) { return pack8(*(const f32x4*)p, *(const f32x4*)(p + 4)); }
    else { return *reinterpret_cast<const bf16x8*>(p); }
}
__device__ __forceinline__ void mask_tile(f32x16& p0, f32x16& p1, int dq, unsigned W) {
    const float NEG = -__builtin_inff();
#pragma unroll
    for (int r = 0; r < 16; ++r) {
        const int c = (r & 3) + 8 * (r >> 2);
        if ((unsigned)(dq - c) >= W) p0[r] = NEG;
        if ((unsigned)(dq - c - 32) >= W) p1[r] = NEG;
    }
}
__device__ __forceinline__ void partialSM(f32x16& p0, f32x16& p1, float& m_reg, float& mn, float& alpha) {
    float pmax = p0[0]; for (int r = 1; r < 16; ++r) pmax = fmaxf(pmax, p0[r]); for (int r = 0; r < 16; ++r) pmax = fmaxf(pmax, p1[r]);
    { auto rr = __builtin_amdgcn_permlane32_swap(__float_as_uint(pmax), __float_as_uint(pmax), false, false);
      pmax = fmaxf(__uint_as_float(rr[0]), __uint_as_float(rr[1])); }
    constexpr float C2 = 1.4426950408889634f * SCALE;
    if (__builtin_expect(__all((pmax - m_reg) * SCALE <= THR), 1)) { mn = m_reg; alpha = 1.f; }
    else { mn = fmaxf(m_reg, pmax); alpha = __builtin_amdgcn_exp2f((m_reg - mn) * C2); m_reg = mn; }
    const float mnL = -mn * C2;
    for (int r = 0; r < 16; ++r) p0[r] = fmaf(p0[r], C2, mnL); for (int r = 0; r < 16; ++r) p1[r] = fmaf(p1[r], C2, mnL);
    for (int r = 0; r < 16; ++r) p0[r] = __builtin_amdgcn_exp2f(p0[r]);
}
__device__ __forceinline__ void finishSM(f32x16& p0, f32x16& p1, float alpha, float& l_reg, bf16x8& pa0, bf16x8& pa1, bf16x8& pa2, bf16x8& pa3) {
    for (int r = 0; r < 16; ++r) p1[r] = __builtin_amdgcn_exp2f(p1[r]);
    float ps = 0; for (int r = 0; r < 16; ++r) ps += p0[r]; for (int r = 0; r < 16; ++r) ps += p1[r];
    { auto rr = __builtin_amdgcn_permlane32_swap(__float_as_uint(ps), __float_as_uint(ps), false, false);
      ps = __uint_as_float(rr[0]) + __uint_as_float(rr[1]); }
    l_reg = l_reg * alpha + ps;
#define PK4(P, B_, OUT) do { unsigned a0 = cvtpk(P[B_+0], P[B_+1]), a1 = cvtpk(P[B_+2], P[B_+3]);                          \
        unsigned b0 = cvtpk(P[B_+4], P[B_+5]), b1 = cvtpk(P[B_+6], P[B_+7]);                                             \
        auto r0 = __builtin_amdgcn_permlane32_swap(a0, b0, false, false); auto r1 = __builtin_amdgcn_permlane32_swap(a1, b1, false, false); \
        u32x4 w = {r0[0], r1[0], r0[1], r1[1]}; OUT = *reinterpret_cast<bf16x8*>(&w); } while (0)
    PK4(p0, 0, pa0); PK4(p0, 8, pa1); PK4(p1, 0, pa2); PK4(p1, 8, pa3);
#undef PK4
}
template <int KB, bool SK, bool NB = false>
__device__ __forceinline__ void qkt(f32x16& p0, f32x16& p1, const char* K_lds, int r32, int hi, const bf16x8* qr, bool act, const float* g_lds, float gt) {
    if (SK && !act) { const float NEG = -__builtin_inff();
#pragma unroll
        for (int r = 0; r < 16; ++r) { p0[r] = NEG; p1[r] = NEG; } return; }
    if constexpr (NB) { p0 = f32x16{}; p1 = f32x16{}; } else
    { const float* gl = g_lds + KB * 64 + 4 * hi;
#pragma unroll
      for (int g4 = 0; g4 < 4; ++g4) { const f32x4 a = *(const f32x4*)(gl + 8 * g4), b = *(const f32x4*)(gl + 32 + 8 * g4);
#pragma unroll
        for (int e = 0; e < 4; ++e) { p0[4 * g4 + e] = a[e]; p1[4 * g4 + e] = b[e]; } } }
    const char* kb[4];
#pragma unroll
    for (int dd = 0; dd < 4; ++dd) kb[dd] = K_lds + KB * SHM_K + KSWZ(r32, (dd * 16 + hi * 8) * 2);
#pragma unroll
    for (int d0 = 0; d0 < 8; ++d0) { const char* a = kb[d0 & 3] + (d0 >> 2) * 128;
        bf16x8 b0 = *reinterpret_cast<const bf16x8*>(a);
        bf16x8 b1 = *reinterpret_cast<const bf16x8*>(a + 32 * 256);
        p0 = __builtin_amdgcn_mfma_f32_32x32x16_bf16(b0, qr[d0], p0, 0, 0, 0);
        p1 = __builtin_amdgcn_mfma_f32_32x32x16_bf16(b1, qr[d0], p1, 0, 0, 0); }
}
template <int VB, bool SK>
__device__ __forceinline__ void pv_tile(f32x16* o, int vb0, bf16x8 pa0, bf16x8 pa1, bf16x8 pa2, bf16x8 pa3, bool act) {
    if (SK && !act) return;
#define TRRD(dst, off) asm volatile("ds_read_b64_tr_b16 %0, %1 offset:%2" : "=&v"(dst) : "v"(vb0), "i"(off) : "memory")
#define PV_D0(d0) do { s16x4 l0, l1, l2, l3, h0, h1, h2, h3; constexpr int b_ = VB * SHM_V + v_rd_off(d0, 0, 0);     \
        TRRD(l0, b_); TRRD(h0, b_ + 2048); TRRD(l1, b_ + 4096); TRRD(h1, b_ + 6144); TRRD(l2, b_ + 8192); TRRD(h2, b_ + 10240); TRRD(l3, b_ + 12288); TRRD(h3, b_ + 14336); \
        asm volatile("s_waitcnt lgkmcnt(0)" ::: "memory"); SBAR();                 \
        o[d0] = __builtin_amdgcn_mfma_f32_32x32x16_bf16(pa0, (bf16x8){l0[0], l0[1], l0[2], l0[3], h0[0], h0[1], h0[2], h0[3]}, o[d0], 0, 0, 0);   \
        o[d0] = __builtin_amdgcn_mfma_f32_32x32x16_bf16(pa1, (bf16x8){l1[0], l1[1], l1[2], l1[3], h1[0], h1[1], h1[2], h1[3]}, o[d0], 0, 0, 0);   \
        o[d0] = __builtin_amdgcn_mfma_f32_32x32x16_bf16(pa2, (bf16x8){l2[0], l2[1], l2[2], l2[3], h2[0], h2[1], h2[2], h2[3]}, o[d0], 0, 0, 0);   \
        o[d0] = __builtin_amdgcn_mfma_f32_32x32x16_bf16(pa3, (bf16x8){l3[0], l3[1], l3[2], l3[3], h3[0], h3[1], h3[2], h3[3]}, o[d0], 0, 0, 0); } while (0)
    PV_D0(0); PV_D0(1); PV_D0(2); PV_D0(3);
#undef PV_D0
#undef TRRD
}

template <class TIn, class TOut> struct BlockRef { const TIn* Q; const TIn* K; const TIn* V; TOut* O; const float* G; int P0; };
template <class TIn> struct Seam {
    bf16x8 qr[8];
    bf16x8 st_v0, st_v1, st_k0, st_k1; f32x4 sf0, sf1, sf2, sf3; float st_g, gt;
    f32x4 tq[16];
};
__device__ __forceinline__ int swa_jlo(int P0, int W) { const int lowk = P0 - W + 1; return lowk > 0 ? lowk / KVBLK : 0; }
#define ROW(p, k0, rr) ((p) + (size_t)((k0) + (rr)) * PITCH + sc)
#define VMW() asm volatile("s_waitcnt vmcnt(0)" ::: "memory")
#define VMWN(n) asm volatile("s_waitcnt vmcnt(%0)" :: "i"(n) : "memory")
#define SLOAD_H(Kp, Vp, Gp, k0) do { const char* kb_ = (const char*)(Kp) + (size_t)(k0) * (PITCH * 2); const char* vb_ = (const char*)(Vp) + (size_t)(k0) * (PITCH * 2); const unsigned vo_ = (unsigned)tid * 16u; \
                         if (wid == 0) S.st_g = *(const float*)((const char*)((Gp) + (k0)) + (vo_ >> 2));                                                    \
                         S.st_v0 = *(const bf16x8*)(vb_ + vo_); S.st_v1 = *(const bf16x8*)(vb_ + 8192 + vo_);                                                \
                         S.st_k0 = *(const bf16x8*)(kb_ + vo_); S.st_k1 = *(const bf16x8*)(kb_ + 8192 + vo_); } while (0)
#define SWRITE_HK(bf) do { if (wid == 0) ((float*)(K_lds + 2 * SHM_K + NW * 256))[(bf) * 64 + lane] = -S.st_g; *(bf16x8*)(K_lds + (bf) * SHM_K + kws) = S.st_k0; *(bf16x8*)(K_lds + (bf) * SHM_K + kws + 32 * 256) = S.st_k1; } while (0)
#define SWRITE_HV(bf) do { *(bf16x8*)(V_lds + (bf) * SHM_V + vst0) = S.st_v0; *(bf16x8*)(V_lds + (bf) * SHM_V + vst1) = S.st_v1; } while (0)
#define SWRITE_H(bf) do { SWRITE_HV(bf); SWRITE_HK(bf); } while (0)
#define SLOAD_F(p, k0) do { S.sf0 = *(const f32x4*)ROW(p, k0, sr); S.sf1 = *(const f32x4*)(ROW(p, k0, sr) + 4);                \
                            S.sf2 = *(const f32x4*)ROW(p, k0, 32 + sr); S.sf3 = *(const f32x4*)(ROW(p, k0, 32 + sr) + 4); } while (0)
#define SWRITE_KF(bf) do { *(bf16x8*)(K_lds + (bf) * SHM_K + kws) = pack8(S.sf0, S.sf1); *(bf16x8*)(K_lds + (bf) * SHM_K + kws + 32 * 256) = pack8(S.sf2, S.sf3); } while (0)
#define SWRITE_VF(bf) do { *(bf16x8*)(V_lds + (bf) * SHM_V + vst0) = pack8(S.sf0, S.sf1); *(bf16x8*)(V_lds + (bf) * SHM_V + vst1) = pack8(S.sf2, S.sf3); } while (0)
template <class TIn, class TOut>
__device__ __forceinline__ void causal_swa_prime(const BlockRef<TIn, TOut>& cur, int W, char* lds, Seam<TIn>& S) {
    constexpr bool F32 = same_t<TIn, float>::v;
    int tid_ = threadIdx.x; asm volatile("" : "+v"(tid_)); const int tid = tid_, wid = __builtin_amdgcn_readfirstlane(tid >> 6), lane = tid & 63, r32 = lane & 31, hi = lane >> 5;
    const int sr = tid >> 4, sc = (tid & 15) * 8, kws = KSWZ(sr, sc * 2); char* K_lds = lds + 2 * SHM_V;
    const int kb0 = ((cur.P0 + QB - 1) / KVBLK) * KVBLK;
    for (int d0 = 0; d0 < 8; ++d0) S.qr[d0] = load8<TIn>(cur.Q + (size_t)(wid * QBLK + r32) * PITCH + d0 * 16 + hi * 8);
    S.gt = 0.f;
    if constexpr (F32) { SLOAD_F((const float*)cur.K, kb0); VMW(); SWRITE_KF(0); SBAR(); SLOAD_F((const float*)cur.V, kb0); }
    else { SLOAD_H(cur.K, cur.V, cur.G, kb0); VMW(); SWRITE_HK(0); }
    __syncthreads();
}
template <class TIn, class TOut, bool NB = false>
__device__ __forceinline__ void causal_swa_block(const BlockRef<TIn, TOut>& cur, const BlockRef<TIn, TOut>& nxt, int skv, int W, char* lds, Seam<TIn>& S) {
    constexpr bool F32 = same_t<TIn, float>::v;
    int tid_ = threadIdx.x; asm volatile("" : "+v"(tid_)); const int tid = tid_, wid = __builtin_amdgcn_readfirstlane(tid >> 6), lane = tid & 63, r32 = lane & 31, hi = lane >> 5;
    const int j_lo = swa_jlo(cur.P0, W);
    int j_hi = (cur.P0 + QB - 1) / KVBLK + 1; if (j_hi > skv / KVBLK) j_hi = skv / KVBLK;
    const int NT = j_hi - j_lo;
    const int kbn = ((nxt.P0 + QB - 1) / KVBLK) * KVBLK;
    const int qlo = cur.P0 + wid * QBLK, qm = qlo + r32 - 4 * hi;
    char* V_lds = lds; char* K_lds = lds + 2 * SHM_V;
    float* ws = (float*)(lds + 2 * SHM_V + 2 * SHM_K) + wid * 64; float* li_l = ws, * al_l = ws + 32;
    float m_reg = -1e30f, l_reg = 0; f32x16 o[4] = {};
    const int sr = tid >> 4, sc = (tid & 15) * 8, vst0 = v_st(sr, sc), vst1 = v_st(32 + sr, sc), kws = KSWZ(sr, sc * 2);
    const int vb0 = (int)(uintptr_t)V_lds + v_rd_base(lane);
    const TIn* Kh = cur.K; const TIn* Vh = cur.V; const float* Gh = cur.G; const float* g_lds = (const float*)(K_lds + 2 * SHM_K + NW * 256);
#define RESC(a) do { if (__any((a) < 1.f)) { if (hi == 0) al_l[r32] = (a); asm volatile("s_waitcnt lgkmcnt(0)" ::: "memory");              \
                     for (int d_ = 0; d_ < 4; ++d_) for (int r = 0; r < 16; ++r) o[d_][r] *= al_l[crow(r, hi)]; } } while (0)
#define KBASE(t) ((j_hi - 1 - (t)) * KVBLK)
#define ACT(t) (KBASE(t) <= qlo + QBLK - 1 && KBASE(t) + KVBLK - 1 >= qlo - W + 1)
#define MASKT(P0_, P1_, t) do { const int kb_ = KBASE(t); if ((!SK || ACT(t)) && (kb_ + KVBLK - 1 > qlo || kb_ <= qlo + QBLK - 1 - W)) mask_tile(P0_, P1_, qm - kb_, (unsigned)W); } while (0)
    constexpr int NQL = F32 ? 16 : 8;
    constexpr bool SK = WSKIP && !F32;
#define SEAM_K0() do { VMWN(NQL); if constexpr (F32) { SWRITE_KF(0); SBAR(); SLOAD_F((const float*)nxt.V, kbn); } else { SWRITE_HK(0); } SBAR(); } while (0)
    f32x16 pA0, pA1, pB0, pB1; float mnA, mnB, alA, alB; bf16x8 pa0, pa1, pa2, pa3;
    if constexpr (F32) { VMW(); SWRITE_VF(0); SBAR(); } else { SWRITE_HV(0); SBAR(); }
    if (NT > 1) { if constexpr (F32) SLOAD_F((const float*)Kh, KBASE(1)); else SLOAD_H(Kh, Vh, Gh, KBASE(1)); }
    SBAR(); qkt<0, SK, NB>(pA0, pA1, K_lds, r32, hi, S.qr, ACT(0), g_lds, S.gt);
    if constexpr (F32) { if (NT > 1) { VMW(); SWRITE_KF(1); SBAR(); SLOAD_F((const float*)Vh, KBASE(1)); } }
    MASKT(pA0, pA1, 0); partialSM(pA0, pA1, m_reg, mnA, alA);
    if (NT > 1) { VMW(); if constexpr (F32) { SWRITE_VF(1); SBAR(); if (NT > 2) SLOAD_F((const float*)Kh, KBASE(2)); } else SWRITE_H(1); }
    __syncthreads();
#define HALF_STEP(PX0, PX1, mnX, alX, PY0, PY1, alY, t, KB, VB, SB) do {                                                      \
        SBAR(); qkt<KB, SK, NB>(PX0, PX1, K_lds, r32, hi, S.qr, ACT(t), g_lds, S.gt);                                             \
        finishSM(PY0, PY1, alY, l_reg, pa0, pa1, pa2, pa3); SBAR();                                                           \
        if ((t) + 1 < NT) { if constexpr (F32) { VMW(); SWRITE_KF(SB); SBAR(); SLOAD_F((const float*)Vh, KBASE((t) + 1)); }  \
                            else { SLOAD_H(Kh, Vh, Gh, KBASE((t) + 1)); } SBAR(); }                                               \
        pv_tile<VB, SK>(o, vb0, pa0, pa1, pa2, pa3, ACT((t) - 1)); MASKT(PX0, PX1, (t)); partialSM(PX0, PX1, m_reg, mnX, alX);                                        \
        __syncthreads();                                                                                                      \
        if ((t) + 1 < NT) { VMW(); if constexpr (F32) { SWRITE_VF(SB); SBAR(); if ((t) + 2 < NT) SLOAD_F((const float*)Kh, KBASE((t) + 2)); } \
                            else { SWRITE_H(SB); } }                                                                          \
        RESC(alX); __syncthreads(); } while (0)
    for (int t = 1; t + 1 < NT; t += 2) {
        HALF_STEP(pB0, pB1, mnB, alB, pA0, pA1, alA, t, 1, 0, 0);
        HALF_STEP(pA0, pA1, mnA, alA, pB0, pB1, alB, t + 1, 0, 1, 1);
    }
    const bool even = (NT & 1) == 0;
    if (even) { SBAR(); qkt<1, SK, NB>(pB0, pB1, K_lds, r32, hi, S.qr, ACT(NT - 1), g_lds, S.gt); SBAR(); }
#define QROW(e) (nxt.Q + (size_t)(wid * QBLK + r32) * PITCH + ((e) >> 1) * 16 + hi * 8 + ((e) & 1) * 4)
    if constexpr (F32) { SLOAD_F((const float*)nxt.K, kbn); SBAR();
#pragma unroll
        for (int e = 0; e < 8; ++e) S.tq[e] = *(const f32x4*)QROW(e); }
    else { SLOAD_H(nxt.K, nxt.V, nxt.G, kbn); SBAR();
#pragma unroll
        for (int d0 = 0; d0 < 8; ++d0) S.qr[d0] = load8<TIn>(nxt.Q + (size_t)(wid * QBLK + r32) * PITCH + d0 * 16 + hi * 8); }
    SBAR();
    finishSM(pA0, pA1, alA, l_reg, pa0, pa1, pa2, pa3); SBAR();
    if constexpr (F32) {
#pragma unroll
        for (int e = 8; e < 16; ++e) S.tq[e] = *(const f32x4*)QROW(e); SBAR(); }
#undef QROW
    pv_tile<0, SK>(o, vb0, pa0, pa1, pa2, pa3, ACT(even ? NT - 2 : NT - 1));
    if (even) { MASKT(pB0, pB1, NT - 1); partialSM(pB0, pB1, m_reg, mnB, alB); __syncthreads(); RESC(alB);
        finishSM(pB0, pB1, alB, l_reg, pa0, pa1, pa2, pa3); SBAR(); pv_tile<1, SK>(o, vb0, pa0, pa1, pa2, pa3, ACT(NT - 1)); }
    SBAR(); SEAM_K0();
    if (hi == 0) li_l[r32] = l_reg; asm volatile("s_waitcnt lgkmcnt(0)" ::: "memory");
    float rli[16];
#pragma unroll
    for (int r = 0; r < 16; ++r) rli[r] = __builtin_amdgcn_rcpf(li_l[crow(r, hi)]);
    TOut* Ow = cur.O + (size_t)(wid * QBLK) * OPITCH;
#pragma unroll
    for (int r = 0; r < 16; ++r) { const int orow = crow(r, hi);
#pragma unroll
        for (int d0 = 0; d0 < 4; ++d0) { const float v = o[d0][r] * rli[r];
            if constexpr (same_t<TOut, float>::v) { Ow[(size_t)orow * OPITCH + d0 * 32 + r32] = v; }
            else { const float vn = __shfl_xor(v, 1);
                   if ((r32 & 1) == 0) *(unsigned*)(Ow + (size_t)orow * OPITCH + d0 * 32 + r32) = cvtpk(v, vn); } } }
    if constexpr (F32) {
#pragma unroll
        for (int d0 = 0; d0 < 8; ++d0) S.qr[d0] = pack8(S.tq[2 * d0], S.tq[2 * d0 + 1]); }
    __syncthreads();
#undef RESC
#undef KBASE
#undef ACT
#undef MASKT
#undef SEAM_K0
#undef HALF_STEP
}
#undef ROW
#undef VMW
#undef VMWN
#undef SLOAD_H
#undef SWRITE_HK
#undef SWRITE_HV
#undef SWRITE_H
#undef SLOAD_F
#undef SWRITE_KF
#undef SWRITE_VF

}
#ifndef MK_ONE_LAUNCH
#define MK_ONE_LAUNCH 1
#endif
#define LAS __attribute__((address_space(3)))
typedef unsigned short bf16;
typedef float f32x4 __attribute__((ext_vector_type(4)));
typedef unsigned u32x4 __attribute__((ext_vector_type(4)));
typedef unsigned u32x2 __attribute__((ext_vector_type(2)));
typedef short bf16x8 __attribute__((ext_vector_type(8)));

constexpr int BATCH = 4, SEQ = 4096, DM = 2048, M = BATCH * SEQ, FFH = 5632, NMOD = 6, MODS = NMOD * DM, NBIN = 3 * DM + 16, NH = 16;
constexpr float EPS = 1e-6f;
constexpr int NWAVES = 8, NTHR = 512;
constexpr int LDS_BYTES = 153600;
constexpr int NPHASE = 16;

constexpr size_t MiB = 1u << 20;
constexpr size_t WS_CTL = 0, WS_MOD = 1 * MiB, ZERO_BYTES = 2 * MiB;
constexpr size_t WS_LOGF = 2 * MiB, WS_G = 3 * MiB, WS_WM = 4 * MiB;
constexpr size_t WS_WAIN = 8 * MiB, WS_WAOUT = 24 * MiB, WS_WBIN = 32 * MiB, WS_WBOUT = 56 * MiB, WS_WGU = 64 * MiB, WS_WDN = 152 * MiB;
constexpr size_t WS_H = 196 * MiB;
constexpr size_t WS_R1 = 260 * MiB;
constexpr size_t WS_RA = 452 * MiB;
constexpr size_t WS_X = 628 * MiB, WS_END = 756 * MiB;
constexpr size_t SZ_ACT = (size_t)M * DM * 2;

struct Args { const float* in[20]; float* out; unsigned char* ws; int ph_lo, ph_hi; };

#define LDS_WAIT() asm volatile("s_waitcnt lgkmcnt(0)" ::: "memory")
__device__ __forceinline__ unsigned pk_bf16(float lo, float hi) { unsigned r; asm volatile("v_cvt_pk_bf16_f32 %0, %1, %2" : "=v"(r) : "v"(lo), "v"(hi)); return r; }
__device__ __forceinline__ float bf_lo(unsigned w) { return __uint_as_float(w << 16); }
__device__ __forceinline__ float bf_hi(unsigned w) { return __uint_as_float(w & 0xffff0000u); }
__device__ __forceinline__ float wave_sum(float v) {
#pragma unroll
    for (int o = 1; o < 64; o <<= 1) v += __shfl_xor(v, o);
    return v;
}

typedef __attribute__((address_space(1))) unsigned gu32;
constexpr int CW_BAR = 4096;
constexpr int MISC_OFF = LDS_BYTES - 64;
#define XB_TMO      128
#define XB_XCNT(j)  (256  + 64 * (j))
#define XB_XSUB(j)  (1280 + 64 * (j))
#define XB_XGEN(j)  (2304 + 64 * (j))
#define XB_TOP      3328
#define XB_TOPGEN   3392
#define XCD_BAR_WORDS 3456
#define XB_SPIN_CAP (1u << 18)

__device__ __forceinline__ unsigned xb_ld(unsigned* p)              { return __hip_atomic_load(p, __ATOMIC_RELAXED, __HIP_MEMORY_SCOPE_AGENT); }
__device__ __forceinline__ unsigned xb_add(unsigned* p, unsigned v) { return __hip_atomic_fetch_add(p, v, __ATOMIC_RELAXED, __HIP_MEMORY_SCOPE_AGENT); }
__device__ __forceinline__ unsigned xb_xcc_id() { return (unsigned)__builtin_amdgcn_s_getreg((3 << 11) | 20) & 0xFu; }
#define XB_SPIN(cond, bar) do { unsigned _sp = 0; while (cond) { __builtin_amdgcn_s_sleep(1); \
    if ((++_sp & 255u) == 0u) { if (xb_ld(&(bar)[XB_TMO])) break; if (_sp > XB_SPIN_CAP) { atomicAdd(&(bar)[XB_TMO], 1u); break; } } } } while (0)

struct XcdBarrier {
    unsigned* bar; unsigned x;
    volatile LAS unsigned* st;
};

__device__ __forceinline__ XcdBarrier xcd_barrier_post(unsigned* bar, volatile LAS unsigned* st) {
    XcdBarrier b; b.bar = bar; b.x = xb_xcc_id(); b.st = st;
    if (threadIdx.x == 0) (void)xb_add(&bar[XB_XCNT(b.x)], 1u);
    return b;
}
__device__ __forceinline__ void xcd_barrier_complete(unsigned* bar, unsigned x, unsigned& nloc, unsigned& nx) {
    const unsigned G = gridDim.x * gridDim.y * gridDim.z;
    unsigned sum, cnt, mine, sp = 0u;
    for (;;) {
        sum = 0u; cnt = 0u; mine = 0u;
#pragma unroll
        for (unsigned j = 0; j < 16; ++j) { const unsigned c = xb_ld(&bar[XB_XCNT(j)]); sum += c; cnt += (c > 0u) ? 1u : 0u; mine = (j == x) ? c : mine; }
        if (sum == G) break;
        __builtin_amdgcn_s_sleep(1);
        if ((++sp & 255u) == 0u) { if (xb_ld(&bar[XB_TMO])) break; if (sp > XB_SPIN_CAP) { atomicAdd(&bar[XB_TMO], 1u); break; } }
    }
    nloc = mine > 0u ? mine : 1u; nx = cnt > 0u ? cnt : 1u;
}

__device__ __forceinline__ void xcd_barrier(const XcdBarrier& b) {
    asm volatile("s_waitcnt vmcnt(0)" ::: "memory");
    __syncthreads();
    if (threadIdx.x == 0) {
        unsigned* bar = b.bar;
        __builtin_amdgcn_s_waitcnt(0);
        unsigned nloc = b.st[0], nx = b.st[1];
        if (nloc == 0u) { xcd_barrier_complete(bar, b.x, nloc, nx); b.st[0] = nloc; b.st[1] = nx; }
        const unsigned old = xb_add(&bar[XB_XSUB(b.x)], 1u);
        const unsigned gen = old / nloc;
        if (old + 1u == (gen + 1u) * nloc) {
            __builtin_amdgcn_fence(__ATOMIC_RELEASE, "agent");
            asm volatile("s_waitcnt vmcnt(0)" ::: "memory");
            const unsigned og = xb_add(&bar[XB_TOP], 1u);
            const unsigned tg = og / nx;
            if (og + 1u == (tg + 1u) * nx) xb_add(&bar[XB_TOPGEN], 1u);
            else XB_SPIN(xb_ld(&bar[XB_TOPGEN]) == tg, bar);
            __builtin_amdgcn_fence(__ATOMIC_ACQUIRE, "agent");
            xb_add(&bar[XB_XGEN(b.x)], 1u);
            asm volatile("s_waitcnt vmcnt(0)" ::: "memory");
        } else {
            XB_SPIN(xb_ld(&bar[XB_XGEN(b.x)]) == gen, bar);
            __builtin_amdgcn_fence(__ATOMIC_ACQUIRE, "agent");
            asm volatile("s_waitcnt vmcnt(0)" ::: "memory");
        }
    }
    __syncthreads();
}

__device__ __forceinline__ void transpose_item(const float* __restrict__ W, int ldw, int Kd, bf16* __restrict__ WT, int k0, int n0, int drow0, LAS float* scr, int lane) {
    {   f32x4 v[8];
        const float* wp = W + (size_t)(k0 + (lane >> 3)) * ldw + n0 + (lane & 7) * 4;
#pragma unroll
        for (int i = 0; i < 8; ++i) v[i] = __builtin_nontemporal_load((const f32x4*)(wp + (size_t)(8 * i) * ldw));
#pragma unroll
        for (int i = 0; i < 8; ++i) { LAS float* d = scr + (8 * i + (lane >> 3)) * 33 + (lane & 7) * 4; d[0] = v[i].x; d[1] = v[i].y; d[2] = v[i].z; d[3] = v[i].w; } }
    LDS_WAIT(); asm volatile("" ::: "memory");
    const int c = lane & 7;
#pragma unroll
    for (int j = 0; j < 4; ++j) { const int n = (lane >> 3) + 8 * j; const LAS float* s = scr + (8 * c) * 33 + n;
        u32x4 o; o.x = pk_bf16(s[0 * 33], s[1 * 33]); o.y = pk_bf16(s[2 * 33], s[3 * 33]); o.z = pk_bf16(s[4 * 33], s[5 * 33]); o.w = pk_bf16(s[6 * 33], s[7 * 33]);
        *(u32x4*)(WT + (size_t)(drow0 + n) * Kd + k0 + 8 * c) = o; }
    LDS_WAIT(); asm volatile("" ::: "memory");
}

__device__ __forceinline__ void mod_task(int t, const LAS float* scl, const float* __restrict__ ada_w, const float* __restrict__ ada_b, float* mod, int lane) {
    const int i = t >> 10, rem = t & 1023, cc = (rem & 7) + 8 * ((rem >> 7) & 7), ks = (rem >> 3) & 15;
    const int col = cc * 192 + lane * 4; const bool on = lane < 48;
    f32x4 acc[4];
#pragma unroll
    for (int b = 0; b < 4; ++b) acc[b] = (f32x4){0.f, 0.f, 0.f, 0.f};
    const float* wp = ada_w + ((size_t)i * DM + ks * 128) * MODS + (on ? col : 0);
#pragma unroll 8
    for (int kk = 0; kk < 128; ++kk) {
        const f32x4 w = *(const f32x4*)(wp + (size_t)kk * MODS);
        const int k = ks * 128 + kk;
        const f32x4 sv = *(const LAS f32x4*)(scl + 4 * k);
        acc[0] += sv.x * w; acc[1] += sv.y * w; acc[2] += sv.z * w; acc[3] += sv.w * w;
    }
    if (on) {
        if (ks == 0) { const f32x4 bv = *(const f32x4*)(ada_b + (size_t)i * MODS + col);
#pragma unroll
            for (int b = 0; b < 4; ++b) acc[b] += bv; }
#pragma unroll
        for (int b = 0; b < 4; ++b) { float* mp = mod + ((size_t)i * BATCH + b) * MODS + col;
            atomicAdd(mp + 0, acc[b][0]); atomicAdd(mp + 1, acc[b][1]); atomicAdd(mp + 2, acc[b][2]); atomicAdd(mp + 3, acc[b][3]); }
    }
}

struct P0Ptrs { const float *a_w_in, *a_w_out, *b_w_in, *b_w_out, *w_gate, *w_up, *w_down, *a_w_s, *c, *ada_w, *ada_b; bf16 *WAin, *WAout, *WBin, *WBout, *Wgu, *Wdn, *Wm; float* mod; };
template <int ONLY = 0>
__device__ __forceinline__ void p0_prologue(LAS unsigned char* lds, const P0Ptrs& P, int vcu, int G, int tid, int wave, int lane) {
    LAS float* scr = (LAS float*)(lds + wave * 16384);
    const int gw = vcu * NWAVES + wave, NGW = G * NWAVES;
    {   LAS float* scl = (LAS float*)lds;
        for (int idx = tid; idx < BATCH * DM; idx += NTHR) { const int k = idx >> 2, b = idx & 3; const float cv = P.c[b * DM + k]; scl[idx] = cv / (1.0f + __expf(-cv)); }
        __syncthreads();
        for (int t = gw; t < 2048; t += NGW) mod_task(t, scl, P.ada_w, P.ada_b, P.mod, lane);
        __syncthreads(); }
    if (ONLY == 1) return;
    for (int idx = gw * 64 + lane; idx < NH * 128 * 128; idx += NGW * 64) { const int tt = (idx >> 7) & 127, s = idx & 127; P.Wm[idx] = (s <= tt) ? (bf16)(pk_bf16(P.a_w_s[idx], 0.f) & 0xffffu) : (bf16)0; }
    constexpr int I_AIN = 32 * 128, I_AOUT = 32 * 64, I_BIN = 32 * 192, I_BOUT = 32 * 64, I_G = 32 * 176, I_D = 88 * 64;
    constexpr int NITEMS = I_AIN + I_AOUT + I_BIN + I_BOUT + 4 * I_G + 2 * I_D;
    for (int it = gw; it < NITEMS; it += NGW) {
        int r = it;
        if (r < I_AIN) { const int kb = r / 128, nb = r % 128; transpose_item(P.a_w_in, 2 * DM, DM, P.WAin, 64 * kb, 32 * nb, 32 * nb, scr, lane); continue; } r -= I_AIN;
        if (r < I_AOUT) { const int kb = r / 64, nb = r % 64; transpose_item(P.a_w_out, DM, DM, P.WAout, 64 * kb, 32 * nb, 32 * nb, scr, lane); continue; } r -= I_AOUT;
        if (r < I_BIN) { const int kb = r / 192, nb = r % 192; transpose_item(P.b_w_in, NBIN, DM, P.WBin, 64 * kb, 32 * nb, 32 * nb, scr, lane); continue; } r -= I_BIN;
        if (r < I_BOUT) { const int kb = r / 64, nb = r % 64; transpose_item(P.b_w_out, DM, DM, P.WBout, 64 * kb, 32 * nb, 32 * nb, scr, lane); continue; } r -= I_BOUT;
        if (r < 4 * I_G) { const int which = r / I_G, rr = r % I_G, layer = which >> 1, isup = which & 1, kb = rr / 176, nb = rr % 176, n0 = 32 * nb;
            const float* W = (isup ? P.w_up : P.w_gate) + (size_t)layer * DM * FFH;
            transpose_item(W, FFH, DM, P.Wgu + (size_t)layer * 2 * FFH * DM, 64 * kb, n0, 256 * (n0 >> 7) + (n0 & 127) + 128 * isup, scr, lane); continue; } r -= 4 * I_G;
        { const int layer = r / I_D, rr = r % I_D, kb = rr / 64, nb = rr % 64;
            transpose_item(P.w_down + (size_t)layer * FFH * DM, DM, FFH, P.Wdn + (size_t)layer * DM * FFH, 64 * kb, 32 * nb, 32 * nb, scr, lane); }
    }
}

constexpr int WTP = DM + 4;
template <int MODE, bool INBF>
__device__ __forceinline__ void norm_phase(LAS unsigned char* lds, const void* __restrict__ xin_, const float* __restrict__ gvec, const float* shift, const float* scale,
                                           bf16* outb, float* outf, const float* __restrict__ wf, const float* __restrict__ bfv, float* logf_out, int tid, int wave, int lane) {
    LAS float* cA = (LAS float*)lds; LAS float* cB = cA + DM; LAS float* wT = (LAS float*)(lds + 16384);
    for (int blk = blockIdx.x; blk < M / 64; blk += gridDim.x) {
        const int b = (blk * 64) / SEQ;
        __syncthreads();
        for (int cidx = tid; cidx < DM; cidx += NTHR) { const float g = gvec[cidx];
            if (MODE != 1) { cA[cidx] = g * (1.0f + scale[(size_t)b * MODS + cidx]); cB[cidx] = shift[(size_t)b * MODS + cidx]; } else { cA[cidx] = g; cB[cidx] = 0.f; } }
        if (MODE == 2 && blk == (int)blockIdx.x) {
            for (int idx = tid; idx < DM * 16; idx += NTHR) { const int k = idx >> 4, hh = idx & 15; wT[hh * WTP + k] = wf[(size_t)k * NBIN + 3 * DM + hh]; } }
        __syncthreads();
        constexpr int RB = (MODE == 2) ? 2 : 1;
        for (int i0 = 0; i0 < 8; i0 += RB) {
            f32x4 v[RB][8];
#pragma unroll
            for (int q = 0; q < RB; ++q) { const int row = blk * 64 + wave + 8 * (i0 + q);
                if (INBF) { const u32x2* xr = (const u32x2*)((const bf16*)xin_ + (size_t)row * DM) + lane;
#pragma unroll
                    for (int j = 0; j < 8; ++j) { const u32x2 w = xr[64 * j]; v[q][j] = (f32x4){bf_lo(w.x), bf_hi(w.x), bf_lo(w.y), bf_hi(w.y)}; }
                } else { const f32x4* xr = (const f32x4*)((const float*)xin_ + (size_t)row * DM) + lane;
#pragma unroll
                    for (int j = 0; j < 8; ++j) v[q][j] = xr[64 * j]; } }
#pragma unroll
            for (int q = 0; q < RB; ++q) { const int row = blk * 64 + wave + 8 * (i0 + q); float ss = 0.f;
#pragma unroll
                for (int j = 0; j < 8; ++j) ss += (v[q][j].x * v[q][j].x + v[q][j].y * v[q][j].y) + (v[q][j].z * v[q][j].z + v[q][j].w * v[q][j].w);
                const float rstd = 1.0f / sqrtf(wave_sum(ss) * (1.0f / DM) + EPS);
#pragma unroll
                for (int j = 0; j < 8; ++j) { const f32x4 a = *(const LAS f32x4*)(cA + 4 * (64 * j + lane)), bb = *(const LAS f32x4*)(cB + 4 * (64 * j + lane)); v[q][j] = (v[q][j] * rstd) * a + bb; }
                if (MODE == 1) { f32x4* o = (f32x4*)(outf + (size_t)row * DM) + lane;
#pragma unroll
                    for (int j = 0; j < 8; ++j) o[64 * j] = v[q][j];
                } else { u32x2* o = (u32x2*)(outb + (size_t)row * DM) + lane;
#pragma unroll
                    for (int j = 0; j < 8; ++j) { u32x2 w; w.x = pk_bf16(v[q][j].x, v[q][j].y); w.y = pk_bf16(v[q][j].z, v[q][j].w); o[64 * j] = w; } } }
            if (MODE == 2) {
                float mine[RB];
#pragma unroll
                for (int q = 0; q < RB; ++q) mine[q] = 0.f;
#pragma unroll 2
                for (int hh = 0; hh < 16; ++hh) { float a[RB];
#pragma unroll
                    for (int q = 0; q < RB; ++q) a[q] = 0.f;
#pragma unroll
                    for (int j = 0; j < 8; ++j) { const f32x4 w = *(const LAS f32x4*)(wT + hh * WTP + 4 * (64 * j + lane));
#pragma unroll
                        for (int q = 0; q < RB; ++q) a[q] += (v[q][j].x * w.x + v[q][j].y * w.y) + (v[q][j].z * w.z + v[q][j].w * w.w); }
#pragma unroll
                    for (int q = 0; q < RB; ++q) { const float s = wave_sum(a[q]); mine[q] = (lane == hh) ? s : mine[q]; } }
#pragma unroll
                for (int q = 0; q < RB; ++q) if (lane < 16) { const int row = blk * 64 + wave + 8 * (i0 + q); const float xx = mine[q] + bfv[lane]; const float lf = fminf(xx, 0.f) - log1pf(expf(-fabsf(xx))); logf_out[(size_t)row * 16 + lane] = lf; }
            }
        }
    }
}

__device__ __forceinline__ void cumsum_phase(LAS unsigned char* lds, const float* logf, float* Gout, int tid, int wave, int lane) {
    LAS float* wt = (LAS float*)lds;
    for (int bh = blockIdx.x; bh < BATCH * NH; bh += gridDim.x) {
        const int b = bh >> 4, h = bh & 15; float v[8]; float run = 0.f;
#pragma unroll
        for (int e = 0; e < 8; ++e) { run += logf[((size_t)b * SEQ + tid * 8 + e) * 16 + h]; v[e] = run; }
        float inc = run;
#pragma unroll
        for (int o = 1; o < 64; o <<= 1) { const float t = __shfl_up(inc, o); if (lane >= o) inc += t; }
        __syncthreads();
        if (lane == 63) wt[wave] = inc;
        __syncthreads();
        float off = inc - run;
#pragma unroll
        for (int w = 0; w < NWAVES; ++w) off += (w < wave) ? wt[w] : 0.f;
        float* gp = Gout + (size_t)bh * SEQ + tid * 8;
#pragma unroll
        for (int e = 0; e < 8; ++e) gp[e] = (off + v[e]) * 11.313708498984761f;
    }
    __syncthreads();
}

constexpr int VTP = 136;
__device__ __forceinline__ void sgu_phase(LAS unsigned char* lds, const bf16* __restrict__ U, const bf16* __restrict__ V, bf16* __restrict__ Y, const bf16* __restrict__ Wm,
                                          const float* __restrict__ ln_g, const float* __restrict__ ln_b, const float* __restrict__ b_s, int tid, int wave, int lane) {
    LAS float* st = (LAS float*)lds; LAS bf16* VT = (LAS bf16*)(lds + 1024);
    for (int unit = blockIdx.x; unit < (M / 128) * 2; unit += gridDim.x) {
        const int chunk = unit >> 1, half = unit & 1, row0 = chunk * 128;
        __syncthreads();
        for (int rb = 0; rb < 16; rb += 4) { u32x4 sw[4][4];
#pragma unroll
            for (int q = 0; q < 4; ++q) { const u32x4* vp = (const u32x4*)(V + (size_t)(row0 + wave * 16 + rb + q) * DM) + lane;
#pragma unroll
                for (int j = 0; j < 4; ++j) sw[q][j] = vp[64 * j]; }
#pragma unroll
            for (int q = 0; q < 4; ++q) { const int rl = wave * 16 + rb + q; float s = 0.f, qq = 0.f;
#pragma unroll
                for (int j = 0; j < 4; ++j) { const u32x4 w = sw[q][j];
                    const float x0 = bf_lo(w.x), x1 = bf_hi(w.x), x2 = bf_lo(w.y), x3 = bf_hi(w.y), x4 = bf_lo(w.z), x5 = bf_hi(w.z), x6 = bf_lo(w.w), x7 = bf_hi(w.w);
                    s += ((x0 + x1) + (x2 + x3)) + ((x4 + x5) + (x6 + x7)); qq += ((x0 * x0 + x1 * x1) + (x2 * x2 + x3 * x3)) + ((x4 * x4 + x5 * x5) + (x6 * x6 + x7 * x7)); }
                s = wave_sum(s); qq = wave_sum(qq); const float mean = s * (1.0f / DM); const float var = fmaxf(qq * (1.0f / DM) - mean * mean, 0.f);
                if (lane == 0) { st[2 * rl] = mean; st[2 * rl + 1] = 1.0f / sqrtf(var + EPS); } } }
        __syncthreads();
        const int srow = wave * 16 + (lane & 15), t0 = wave * 16, nks = (wave >> 1) + 1, tq = t0 + (lane & 15);
        const size_t rowoff = (size_t)(row0 + tq) * DM;
        u32x4 vr[4];
#pragma unroll
        for (int i = 0; i < 4; ++i) vr[i] = *(const u32x4*)(V + (size_t)(row0 + srow) * DM + (half * 8) * 128 + ((lane >> 4) + 4 * i) * 8);
        for (int gi = 0; gi < 8; ++gi) {
            const int g = half * 8 + gi;
            bf16x8 af[4]; u32x2 uw[8];
#pragma unroll
            for (int ks = 0; ks < 4; ++ks) af[ks] = *(const bf16x8*)(Wm + ((size_t)(g * 128 + tq) * 128 + ks * 32 + 8 * (lane >> 4)));
#pragma unroll
            for (int n = 0; n < 8; ++n) uw[n] = *(const u32x2*)(U + rowoff + g * 128 + n * 16 + 4 * (lane >> 4));
            const float bs = b_s[g * 128 + tq];
            {   const float mean = st[2 * srow], rstd = st[2 * srow + 1];
#pragma unroll
                for (int i = 0; i < 4; ++i) { const int cc = (lane >> 4) + 4 * i, col = g * 128 + cc * 8; const u32x4 w = vr[i];
                    const f32x4 g0 = *(const f32x4*)(ln_g + col), g1 = *(const f32x4*)(ln_g + col + 4), b0 = *(const f32x4*)(ln_b + col), b1 = *(const f32x4*)(ln_b + col + 4);
                    LAS bf16* vt = VT + (cc * 8) * VTP + srow;
                    vt[0 * VTP] = (bf16)pk_bf16((bf_lo(w.x) - mean) * rstd * g0.x + b0.x, 0.f); vt[1 * VTP] = (bf16)pk_bf16((bf_hi(w.x) - mean) * rstd * g0.y + b0.y, 0.f);
                    vt[2 * VTP] = (bf16)pk_bf16((bf_lo(w.y) - mean) * rstd * g0.z + b0.z, 0.f); vt[3 * VTP] = (bf16)pk_bf16((bf_hi(w.y) - mean) * rstd * g0.w + b0.w, 0.f);
                    vt[4 * VTP] = (bf16)pk_bf16((bf_lo(w.z) - mean) * rstd * g1.x + b1.x, 0.f); vt[5 * VTP] = (bf16)pk_bf16((bf_hi(w.z) - mean) * rstd * g1.y + b1.y, 0.f);
                    vt[6 * VTP] = (bf16)pk_bf16((bf_lo(w.w) - mean) * rstd * g1.z + b1.z, 0.f); vt[7 * VTP] = (bf16)pk_bf16((bf_hi(w.w) - mean) * rstd * g1.w + b1.w, 0.f); } }
            __syncthreads();
            if (gi + 1 < 8) {
#pragma unroll
                for (int i = 0; i < 4; ++i) vr[i] = *(const u32x4*)(V + (size_t)(row0 + srow) * DM + (g + 1) * 128 + ((lane >> 4) + 4 * i) * 8); }
            f32x4 acc[8];
#pragma unroll
            for (int n = 0; n < 8; ++n) acc[n] = (f32x4){0.f, 0.f, 0.f, 0.f};
#pragma unroll
            for (int ks = 0; ks < 4; ++ks) { if (ks < nks) {
#pragma unroll
                for (int n = 0; n < 8; ++n) { const bf16x8 bv = *(const LAS bf16x8*)(VT + (n * 16 + (lane & 15)) * VTP + ks * 32 + 8 * (lane >> 4));
                    acc[n] = __builtin_amdgcn_mfma_f32_16x16x32_bf16(bv, af[ks], acc[n], 0, 0, 0); } } }
#pragma unroll
            for (int n = 0; n < 8; ++n) { const int col = g * 128 + n * 16 + 4 * (lane >> 4); u32x2 yw;
                yw.x = pk_bf16(bf_lo(uw[n].x) * (acc[n][0] + bs), bf_hi(uw[n].x) * (acc[n][1] + bs)); yw.y = pk_bf16(bf_lo(uw[n].y) * (acc[n][2] + bs), bf_hi(uw[n].y) * (acc[n][3] + bs));
                *(u32x2*)(Y + rowoff + col) = yw; }
            __syncthreads();
        }
    }
}

__device__ __forceinline__ fox::BlockRef<bf16, bf16> attn_ref(int L, int pass, const bf16* Q, const bf16* K, const bf16* V, bf16* O, const float* G) {
    const int bh = L >> 3, x = L & 7, qb = pass ? 15 - x : x, b = bh >> 4, h = bh & 15;
    fox::BlockRef<bf16, bf16> r; const size_t koff = (size_t)bh * SEQ * fox::PITCH, qoff = koff + (size_t)qb * fox::QB * fox::PITCH, ooff = ((size_t)b * SEQ + (size_t)qb * fox::QB) * fox::OPITCH + h * 128;
    r.Q = Q + qoff; r.O = O + ooff; r.K = K + koff; r.V = V + koff; r.G = G + (size_t)bh * SEQ; r.P0 = qb * fox::QB;
    return r;
}
template <bool NB = false>
__device__ __forceinline__ void attn_phase(char* lds, const bf16* Q, const bf16* K, const bf16* V, bf16* O, const float* G, int vcu, int nwg) {
    constexpr int total = BATCH * NH * 8;
    int L = vcu; if (L >= total) return;
    int pass = 0;
    fox::BlockRef<bf16, bf16> cur = attn_ref(L, 0, Q, K, V, O, G);
    fox::Seam<bf16> S;
    fox::causal_swa_prime<bf16, bf16>(cur, SEQ, lds, S);
    for (;;) {
        const bool more_pass = pass == 0, more_item = L + nwg < total, last = !more_pass && !more_item;
        int passn = pass + 1, Ln = L;
        if (!more_pass) { passn = 0; Ln = more_item ? L + nwg : L; }
        const fox::BlockRef<bf16, bf16> nxt = last ? cur : attn_ref(Ln, passn, Q, K, V, O, G);
        fox::causal_swa_block<bf16, bf16, NB>(cur, nxt, SEQ, SEQ, lds, S);
        if (last) break;
        cur = nxt; pass = passn; L = Ln;
    }
}

__global__ void __launch_bounds__(NTHR, 2) fwd_kernel(Args args) {
    extern __shared__ __attribute__((aligned(16))) unsigned char lds_raw[];
    LAS unsigned char* lds = (LAS unsigned char*)lds_raw;
    const int G = gridDim.x;
#define INP(i) ((const float*)ka[i])
#define FRESH() int tid = threadIdx.x; asm volatile("" : "+v"(tid)); const int lane = tid & 63, wave = __builtin_amdgcn_readfirstlane(tid >> 6); int bx = blockIdx.x; asm volatile("" : "+s"(bx)); const int vcu = (G % 8 == 0) ? (bx % 8) * (G / 8) + bx / 8 : bx; (void)lane; (void)wave; (void)vcu; const __attribute__((address_space(4))) unsigned long long* ka = (const __attribute__((address_space(4))) unsigned long long*)__builtin_amdgcn_kernarg_segment_ptr(); asm volatile("" : "+s"(ka)); unsigned char* ws = (unsigned char*)ka[21]; const float* x = INP(0); float* mod = (float*)(ws + WS_MOD); float* logf_b = (float*)(ws + WS_LOGF); float* Gb = (float*)(ws + WS_G); bf16* Wm = (bf16*)(ws + WS_WM); bf16* WAin = (bf16*)(ws + WS_WAIN); bf16* WAout = (bf16*)(ws + WS_WAOUT); bf16* WBin = (bf16*)(ws + WS_WBIN); bf16* WBout = (bf16*)(ws + WS_WBOUT); bf16* Wgu = (bf16*)(ws + WS_WGU); bf16* Wdn = (bf16*)(ws + WS_WDN); bf16* Hb = (bf16*)(ws + WS_H); bf16* R1 = (bf16*)(ws + WS_R1); bf16* RA = (bf16*)(ws + WS_RA); bf16* XA = (bf16*)(ws + WS_X); float* XF = (float*)(ws + WS_R1);    (void)x; (void)mod; (void)logf_b; (void)Gb; (void)Wm; (void)WAin; (void)WAout; (void)WBin; (void)WBout; (void)Wgu; (void)Wdn; (void)Hb; (void)R1; (void)RA; (void)XA; (void)XF;
    unsigned char* ws0 = args.ws;
    const int lo = MK_ONE_LAUNCH ? 0 : args.ph_lo, hi = MK_ONE_LAUNCH ? NPHASE : args.ph_hi;
    if (threadIdx.x < 16) ((LAS unsigned*)(lds + MISC_OFF))[threadIdx.x] = 0u;
    __syncthreads();
    XcdBarrier bar = xcd_barrier_post((unsigned*)(ws0 + WS_CTL) + CW_BAR, (volatile LAS unsigned*)(lds + MISC_OFF));
    int ph = 0;
#define IN_PH() (lo <= ph && ph < hi)
#ifdef PROBE_BAR2
#define PROBE_BAR_EXTRA xcd_barrier(bar);
#else
#define PROBE_BAR_EXTRA
#endif
#define SEAM() do { if (IN_PH() && ph + 1 < hi) { if (ph == 0 && args.ph_lo < 0) cg::this_grid().sync(); else { xcd_barrier(bar); PROBE_BAR_EXTRA } } ++ph; } while (0)

    if (IN_PH()) { FRESH();
        P0Ptrs P; P.a_w_in = INP(6); P.a_w_out = INP(12); P.b_w_in = INP(13); P.b_w_out = INP(15); P.w_gate = INP(16); P.w_up = INP(17); P.w_down = INP(18);
        P.a_w_s = INP(10); P.c = INP(1); P.ada_w = INP(2); P.ada_b = INP(3);
        P.WAin = WAin; P.WAout = WAout; P.WBin = WBin; P.WBout = WBout; P.Wgu = Wgu; P.Wdn = Wdn; P.Wm = Wm; P.mod = mod;
        p0_prologue(lds, P, vcu, G, tid, wave, lane);
#ifdef PROBE_P02
        __syncthreads(); P.mod = (float*)(ws + WS_RA); p0_prologue(lds, P, vcu, G, tid, wave, lane); __syncthreads(); p0_prologue(lds, P, vcu, G, tid, wave, lane);
#endif
    }
    SEAM();
    { constexpr int layer = 0;
#undef modl
#define modl (mod + (size_t)layer * BATCH * MODS)
        if (IN_PH()) { FRESH();
            if (layer == 0) { norm_phase<0, false>(lds, x, INP(4), modl, modl + DM, Hb, nullptr, nullptr, nullptr, nullptr, tid, wave, lane);
#ifdef PROBE_NORM2
            __syncthreads(); norm_phase<0, false>(lds, x, INP(4), modl, modl + DM, Hb, nullptr, nullptr, nullptr, nullptr, tid, wave, lane);
#endif
            }
            else { norm_phase<2, true>(lds, XA, INP(4) + DM, modl, modl + DM, Hb, nullptr, INP(13), INP(14), logf_b, tid, wave, lane);
#if defined(PROBE_NORM2) || defined(PROBE_NORM2M)
            __syncthreads(); norm_phase<2, true>(lds, XA, INP(4) + DM, modl, modl + DM, Hb, nullptr, INP(13), INP(14), logf_b, tid, wave, lane);
#endif
            }
        }
        SEAM();
        if (IN_PH()) { FRESH();
            if (layer == 0) {
                pg8::Gemm g{Hb, WAin, M, 2 * DM, DM}; pg8::StaticOrder S; S.init(M, 2 * DM, G, bx);
                pg8::EpiBf16<1> E{R1, DM, INP(7), DM, SZ_ACT / 2, 1.f};
                pg8::gemm_phase<pg8::EpiBf16<1>, pg8::StaticOrder, PG8_ALIGN, PG8_SP2>(lds, g, S, E);
            } else {
                cumsum_phase(lds, logf_b, Gb, tid, wave, lane);
                pg8::Gemm g{Hb, WBin, M, 3 * DM, DM}; pg8::StaticOrder S; S.init(M, 3 * DM, G, bx);
                pg8::EpiQKV E{R1, SZ_ACT / 2, SEQ, NH};
                pg8::gemm_phase<pg8::EpiQKV, pg8::StaticOrder, PG8_ALIGN, PG8_SP2>(lds, g, S, E);
            }
        }
        SEAM();
        if (IN_PH()) { FRESH();
            if (layer == 0) sgu_phase(lds, R1, R1 + SZ_ACT / 2, R1 + SZ_ACT, Wm, INP(8), INP(9), INP(11), tid, wave, lane);
#ifdef PROBE_SGU2
            if (layer == 0) { xcd_barrier(bar); sgu_phase(lds, R1, R1 + SZ_ACT / 2, R1 + SZ_ACT, Wm, INP(8), INP(9), INP(11), tid, wave, lane); }
#endif
            else attn_phase((char*)lds_raw, R1, R1 + SZ_ACT / 2, R1 + SZ_ACT, RA, Gb, vcu, G);
#ifdef PROBE_ATT2
            if (layer == 1) { xcd_barrier(bar); attn_phase<true>((char*)lds_raw, R1, R1 + SZ_ACT / 2, R1 + SZ_ACT, RA + SZ_ACT / 2, Gb, vcu, G); }
#endif
        }
        SEAM();
        if (IN_PH()) { FRESH();
            pg8::Gemm g{(layer == 0) ? (const bf16*)(R1 + SZ_ACT) : (const bf16*)RA, (layer == 0) ? WAout : WBout, M, DM, DM}; pg8::StaticOrder S; S.init(M, DM, G, bx);
            if (layer == 0) { pg8::EpiRes2<float, bf16> E{x, XA, DM, modl + 2 * DM, MODS, SEQ}; pg8::gemm_phase<pg8::EpiRes2<float, bf16>, pg8::StaticOrder, PG8_ALIGN, PG8_SP2>(lds, g, S, E); }
            else { pg8::EpiRes2<bf16, bf16> E{XA, XA, DM, modl + 2 * DM, MODS, SEQ}; pg8::gemm_phase<pg8::EpiRes2<bf16, bf16>, pg8::StaticOrder, PG8_ALIGN, PG8_SP2>(lds, g, S, E); }
        }
        SEAM();
        if (IN_PH()) { FRESH(); norm_phase<0, true>(lds, XA, INP(5) + (size_t)layer * DM, modl + 3 * DM, modl + 4 * DM, Hb, nullptr, nullptr, nullptr, nullptr, tid, wave, lane);
#ifdef PROBE_NORM2
            __syncthreads(); norm_phase<0, true>(lds, XA, INP(5) + (size_t)layer * DM, modl + 3 * DM, modl + 4 * DM, Hb, nullptr, nullptr, nullptr, nullptr, tid, wave, lane);
#endif
 }
        SEAM();
        if (IN_PH()) { FRESH();
            pg8::Gemm g{Hb, Wgu + (size_t)layer * 2 * FFH * DM, M, 2 * FFH, DM}; pg8::StaticOrder S; S.init(M, 2 * FFH, G, bx);
            pg8::EpiSwiGLU E{RA, FFH};
            pg8::gemm_phase<pg8::EpiSwiGLU, pg8::StaticOrder, PG8_ALIGN, PG8_SP2>(lds, g, S, E);
#ifdef PROBE_GU2
            if (layer == 0) { xcd_barrier(bar); pg8::gemm_phase<pg8::EpiSwiGLU, pg8::StaticOrder, PG8_ALIGN, PG8_SP2>(lds, g, S, E); }
#endif
        }
        SEAM();
        if (IN_PH()) { FRESH();
            pg8::Gemm g{RA, Wdn + (size_t)layer * DM * FFH, M, DM, FFH}; pg8::StaticOrder S; S.init(M, DM, G, bx);
            if (layer == 0) { pg8::EpiRes2<bf16, bf16> E{XA, XA, DM, modl + 5 * DM, MODS, SEQ}; pg8::gemm_phase<pg8::EpiRes2<bf16, bf16>, pg8::StaticOrder, PG8_ALIGN, PG8_SP2>(lds, g, S, E); }
            else { pg8::EpiRes2<bf16, float> E{XA, XF, DM, modl + 5 * DM, MODS, SEQ}; pg8::gemm_phase<pg8::EpiRes2<bf16, float>, pg8::StaticOrder, PG8_ALIGN, PG8_SP2>(lds, g, S, E); }
        }
        SEAM();
        }
    { constexpr int layer = 1;
#undef modl
#define modl (mod + (size_t)layer * BATCH * MODS)
        if (IN_PH()) { FRESH();
            if (layer == 0) { norm_phase<0, false>(lds, x, INP(4), modl, modl + DM, Hb, nullptr, nullptr, nullptr, nullptr, tid, wave, lane);
#ifdef PROBE_NORM2
            __syncthreads(); norm_phase<0, false>(lds, x, INP(4), modl, modl + DM, Hb, nullptr, nullptr, nullptr, nullptr, tid, wave, lane);
#endif
            }
            else { norm_phase<2, true>(lds, XA, INP(4) + DM, modl, modl + DM, Hb, nullptr, INP(13), INP(14), logf_b, tid, wave, lane);
#if defined(PROBE_NORM2) || defined(PROBE_NORM2M)
            __syncthreads(); norm_phase<2, true>(lds, XA, INP(4) + DM, modl, modl + DM, Hb, nullptr, INP(13), INP(14), logf_b, tid, wave, lane);
#endif
            }
        }
        SEAM();
        if (IN_PH()) { FRESH();
            if (layer == 0) {
                pg8::Gemm g{Hb, WAin, M, 2 * DM, DM}; pg8::StaticOrder S; S.init(M, 2 * DM, G, bx);
                pg8::EpiBf16<1> E{R1, DM, INP(7), DM, SZ_ACT / 2, 1.f};
                pg8::gemm_phase<pg8::EpiBf16<1>, pg8::StaticOrder, PG8_ALIGN, PG8_SP2>(lds, g, S, E);
            } else {
                cumsum_phase(lds, logf_b, Gb, tid, wave, lane);
                pg8::Gemm g{Hb, WBin, M, 3 * DM, DM}; pg8::StaticOrder S; S.init(M, 3 * DM, G, bx);
                pg8::EpiQKV E{R1, SZ_ACT / 2, SEQ, NH};
                pg8::gemm_phase<pg8::EpiQKV, pg8::StaticOrder, PG8_ALIGN, PG8_SP2>(lds, g, S, E);
            }
        }
        SEAM();
        if (IN_PH()) { FRESH();
            if (layer == 0) sgu_phase(lds, R1, R1 + SZ_ACT / 2, R1 + SZ_ACT, Wm, INP(8), INP(9), INP(11), tid, wave, lane);
#ifdef PROBE_SGU2
            if (layer == 0) { xcd_barrier(bar); sgu_phase(lds, R1, R1 + SZ_ACT / 2, R1 + SZ_ACT, Wm, INP(8), INP(9), INP(11), tid, wave, lane); }
#endif
            else attn_phase((char*)lds_raw, R1, R1 + SZ_ACT / 2, R1 + SZ_ACT, RA, Gb, vcu, G);
#ifdef PROBE_ATT2
            if (layer == 1) { xcd_barrier(bar); attn_phase<true>((char*)lds_raw, R1, R1 + SZ_ACT / 2, R1 + SZ_ACT, RA + SZ_ACT / 2, Gb, vcu, G); }
#endif
        }
        SEAM();
        if (IN_PH()) { FRESH();
            pg8::Gemm g{(layer == 0) ? (const bf16*)(R1 + SZ_ACT) : (const bf16*)RA, (layer == 0) ? WAout : WBout, M, DM, DM}; pg8::StaticOrder S; S.init(M, DM, G, bx);
            if (layer == 0) { pg8::EpiRes2<float, bf16> E{x, XA, DM, modl + 2 * DM, MODS, SEQ}; pg8::gemm_phase<pg8::EpiRes2<float, bf16>, pg8::StaticOrder, PG8_ALIGN, PG8_SP2>(lds, g, S, E); }
            else { pg8::EpiRes2<bf16, bf16> E{XA, XA, DM, modl + 2 * DM, MODS, SEQ}; pg8::gemm_phase<pg8::EpiRes2<bf16, bf16>, pg8::StaticOrder, PG8_ALIGN, PG8_SP2>(lds, g, S, E); }
        }
        SEAM();
        if (IN_PH()) { FRESH(); norm_phase<0, true>(lds, XA, INP(5) + (size_t)layer * DM, modl + 3 * DM, modl + 4 * DM, Hb, nullptr, nullptr, nullptr, nullptr, tid, wave, lane);
#ifdef PROBE_NORM2
            __syncthreads(); norm_phase<0, true>(lds, XA, INP(5) + (size_t)layer * DM, modl + 3 * DM, modl + 4 * DM, Hb, nullptr, nullptr, nullptr, nullptr, tid, wave, lane);
#endif
 }
        SEAM();
        if (IN_PH()) { FRESH();
            pg8::Gemm g{Hb, Wgu + (size_t)layer * 2 * FFH * DM, M, 2 * FFH, DM}; pg8::StaticOrder S; S.init(M, 2 * FFH, G, bx);
            pg8::EpiSwiGLU E{RA, FFH};
            pg8::gemm_phase<pg8::EpiSwiGLU, pg8::StaticOrder, PG8_ALIGN, PG8_SP2>(lds, g, S, E);
#ifdef PROBE_GU2
            if (layer == 0) { xcd_barrier(bar); pg8::gemm_phase<pg8::EpiSwiGLU, pg8::StaticOrder, PG8_ALIGN, PG8_SP2>(lds, g, S, E); }
#endif
        }
        SEAM();
        if (IN_PH()) { FRESH();
            pg8::Gemm g{RA, Wdn + (size_t)layer * DM * FFH, M, DM, FFH}; pg8::StaticOrder S; S.init(M, DM, G, bx);
            if (layer == 0) { pg8::EpiRes2<bf16, bf16> E{XA, XA, DM, modl + 5 * DM, MODS, SEQ}; pg8::gemm_phase<pg8::EpiRes2<bf16, bf16>, pg8::StaticOrder, PG8_ALIGN, PG8_SP2>(lds, g, S, E); }
            else { pg8::EpiRes2<bf16, float> E{XA, XF, DM, modl + 5 * DM, MODS, SEQ}; pg8::gemm_phase<pg8::EpiRes2<bf16, float>, pg8::StaticOrder, PG8_ALIGN, PG8_SP2>(lds, g, S, E); }
        }
        SEAM();
        }
    if (IN_PH()) { FRESH(); norm_phase<1, false>(lds, XF, INP(19), nullptr, nullptr, nullptr, (float*)ka[20], nullptr, nullptr, nullptr, tid, wave, lane);
#ifdef PROBE_NORM2
            __syncthreads(); norm_phase<1, false>(lds, XF, INP(19), nullptr, nullptr, nullptr, (float*)ka[20], nullptr, nullptr, nullptr, tid, wave, lane);
#endif
 }
#undef IN_PH
#undef SEAM
}

extern "C" void kernel_launch(void* const* d_in, const int* in_sizes, int n_in, void* d_out, int out_size, void* d_ws, size_t ws_size, hipStream_t stream) {
    static int grid = 0;
    if (grid == 0) {
        if (n_in != 20 || in_sizes[0] != M * DM || out_size != M * DM || ws_size < WS_END) { fprintf(stderr, "kernel_launch: unexpected shapes (n_in %d, in0 %d, out %d, ws %zu)\n", n_in, n_in > 0 ? in_sizes[0] : -1, out_size, ws_size); grid = -1; return; }
        int dev = 0, cus = 0, per_cu = 0;
        (void)hipGetDevice(&dev); (void)hipDeviceGetAttribute(&cus, hipDeviceAttributeMultiprocessorCount, dev);
        if (hipFuncSetAttribute((const void*)fwd_kernel, hipFuncAttributeMaxDynamicSharedMemorySize, LDS_BYTES) != hipSuccess) { fprintf(stderr, "kernel_launch: hipFuncSetAttribute failed\n"); grid = -1; return; }
        if (hipOccupancyMaxActiveBlocksPerMultiprocessor(&per_cu, (const void*)fwd_kernel, NTHR, LDS_BYTES) != hipSuccess || per_cu < 1) { fprintf(stderr, "kernel_launch: occupancy query says %d\n", per_cu); per_cu = 1; }
        (void)hipGetLastError();
        grid = cus > 0 ? cus : 256;
        fprintf(stderr, "kernel_launch: grid %d (cus %d, per_cu %d)\n", grid, cus, per_cu);
    }
    if (grid < 0) return;
    (void)hipMemsetAsync((char*)d_ws + WS_CTL, 0, ZERO_BYTES, stream);
    Args a{};
    for (int i = 0; i < 20; ++i) a.in[i] = (const float*)d_in[i];
    a.out = (float*)d_out; a.ws = (unsigned char*)d_ws;
#if MK_ONE_LAUNCH
    a.ph_lo = 0; a.ph_hi = NPHASE;
    void* kargs[] = {&a};
    hipError_t e = hipLaunchCooperativeKernel((const void*)fwd_kernel, dim3(grid), dim3(NTHR), kargs, LDS_BYTES, stream);
    if (e != hipSuccess) fprintf(stderr, "kernel_launch: cooperative launch failed: %s (grid %d)\n", hipGetErrorString(e), grid);
#else
    for (int p = 0; p < NPHASE; ++p) { a.ph_lo = p; a.ph_hi = p + 1; hipLaunchKernelGGL(fwd_kernel, dim3(grid), dim3(NTHR), LDS_BYTES, stream, a); }
#endif
}
```
